# Optimizing an MI355X kernel written in HIP

```python
import math
import jax, jax.numpy as jnp
from jax import lax
import numpy as np

D_MODEL = 1024
BATCH = 1
SEQ = 16384
DEPTH = 2

A_PATTERNS = ((128, 1), (512, 4), (2048, 16))
A_GROUPS = 3
A_HEADS = 8
A_HEAD_DIM = 64
A_WIDTH = A_HEADS * A_HEAD_DIM
A_BLOCK = 128
M_HEADS = 16
M_Q_LORA = 256
M_KV_LORA = 128
M_NOPE = 64
M_ROPE = 32
M_V = 64
M_WIDTH = M_HEADS * M_V
ROPE_THETA = 10000.0
Q_BLOCK = 128
REL_BUCKETS = 32
REL_MAX_DIST = 2048
N_BIAS_HEADS = A_GROUPS * A_HEADS
EPS = 1e-6
NEG_INF = -1e30

SPLIT_SIZES = (3 * A_GROUPS * A_WIDTH, A_WIDTH, M_Q_LORA, M_KV_LORA, M_ROPE, M_WIDTH, 2 * D_MODEL)
D_IN = sum(SPLIT_SIZES)
SPLIT_IDX = tuple(sum(SPLIT_SIZES[:i + 1]) for i in range(len(SPLIT_SIZES) - 1))

kernel_name = 'hybrid_dilated_mla_gated_block'


def rms_norm(x, g):
    xf = x.astype(jnp.float32)
    y = xf * lax.rsqrt(jnp.mean(xf * xf, axis=-1, keepdims=True) + EPS)
    return (y * g.astype(jnp.float32)).astype(x.dtype)


def t5_bucket(dist):
    exact = REL_BUCKETS // 2
    d = jnp.maximum(dist, 1).astype(jnp.float32)
    large = exact + (jnp.log(d / exact) / math.log(REL_MAX_DIST / exact) * (REL_BUCKETS - exact)).astype(jnp.int32)
    large = jnp.minimum(large, REL_BUCKETS - 1)
    return jnp.where(dist < exact, dist, large)


def apply_rope(t, cos, sin):
    half = t.shape[-1] // 2
    t1 = t[..., :half].astype(jnp.float32)
    t2 = t[..., half:].astype(jnp.float32)
    return jnp.concatenate([t1 * cos - t2 * sin, t1 * sin + t2 * cos], axis=-1).astype(t.dtype)


def dilated_attention_group(q, k, v, bias_tab, window, dilation):
    B, S, H, Dh = q.shape
    r = dilation
    n_rel = window // r
    L = -(-S // r)
    nb = -(-L // A_BLOCK)
    Lp = nb * A_BLOCK
    pad = Lp * r - S

    def to_blocks(t):
        t = jnp.pad(t, ((0, 0), (0, pad), (0, 0), (0, 0)))
        t = t.reshape(B, Lp, r, H, Dh).transpose(0, 2, 1, 3, 4)
        return t.reshape(B, r, nb, A_BLOCK, H, Dh)

    def with_prev(t):
        prev = jnp.concatenate([jnp.zeros_like(t[:, :, :1]), t[:, :, :-1]], axis=2)
        return jnp.concatenate([prev, t], axis=3)

    qb = to_blocks(q)
    kw = with_prev(to_blocks(k))
    vw = with_prev(to_blocks(v))
    s = jnp.einsum('bpnqhd,bpnkhd->bpnhqk', qb, kw).astype(jnp.float32) * (Dh ** -0.5)
    qi = jnp.arange(A_BLOCK)[:, None]
    ki = jnp.arange(2 * A_BLOCK)[None, :]
    j = qi + A_BLOCK - ki
    band = (j >= 0) & (j <= n_rel)
    bias = bias_tab[t5_bucket(jnp.maximum(j, 0) * r)].astype(jnp.float32).transpose(2, 0, 1)
    key_sub = jnp.arange(nb)[:, None, None] * A_BLOCK + ki[None] - A_BLOCK
    valid = band[None] & (key_sub >= 0)
    s = jnp.where(valid[None, None, :, None], s + bias, NEG_INF)
    m = jnp.max(s, axis=-1, keepdims=True)
    p = jnp.exp(s - m)
    l = jnp.sum(p, axis=-1, keepdims=True)
    o = jnp.einsum('bpnhqk,bpnkhd->bpnqhd', (p / l).astype(v.dtype), vw)
    lse = (m + jnp.log(l))[..., 0]
    o = o.reshape(B, r, Lp, H, Dh).transpose(0, 2, 1, 3, 4).reshape(B, Lp * r, H, Dh)[:, :S]
    lse = lse.transpose(0, 1, 2, 4, 3).reshape(B, r, Lp, H).transpose(0, 2, 1, 3).reshape(B, Lp * r, H)[:, :S]
    return o, lse


def dilated_mixer(a_qkv, rel_bias):
    B, S, _ = a_qkv.shape
    qkv = a_qkv.reshape(B, S, 3, A_GROUPS, A_HEADS, A_HEAD_DIM)
    outs, lses = [], []
    for g, (w, r) in enumerate(A_PATTERNS):
        o, lse = dilated_attention_group(qkv[:, :, 0, g], qkv[:, :, 1, g], qkv[:, :, 2, g],
                                         rel_bias[:, g * A_HEADS:(g + 1) * A_HEADS], w, r)
        outs.append(o)
        lses.append(lse)
    wts = jax.nn.softmax(jnp.stack(lses), axis=0)
    o = jnp.sum(jnp.stack(outs).astype(jnp.float32) * wts[..., None], axis=0)
    return o.reshape(B, S, A_WIDTH).astype(a_qkv.dtype)


def mla_mixer(c_q, c_kv, k_rope_raw, q_norm_g, w_uq, kv_norm_g, w_ukv, cos, sin):
    B, S, _ = c_q.shape
    q = (rms_norm(c_q, q_norm_g) @ w_uq).reshape(B, S, M_HEADS, M_NOPE + M_ROPE)
    q_nope = q[..., :M_NOPE]
    q_rope = apply_rope(q[..., M_NOPE:], cos[:, :, None], sin[:, :, None])
    kv = (rms_norm(c_kv, kv_norm_g) @ w_ukv).reshape(B, S, M_HEADS, M_NOPE + M_V)
    k_nope = kv[..., :M_NOPE]
    v = kv[..., M_NOPE:]
    k_rope = apply_rope(k_rope_raw, cos, sin)
    nb = S // Q_BLOCK
    scale = (M_NOPE + M_ROPE) ** -0.5
    k_pos = jnp.arange(S)

    def blocks(t):
        return t.reshape((B, nb, Q_BLOCK) + t.shape[2:]).swapaxes(0, 1)

    def attend(args):
        qn, qr, start = args
        s = (jnp.einsum('bqhd,bkhd->bhqk', qn, k_nope)
             + jnp.einsum('bqhd,bkd->bhqk', qr, k_rope)).astype(jnp.float32) * scale
        q_pos = start + jnp.arange(Q_BLOCK)
        s = jnp.where(k_pos[None, :] <= q_pos[:, None], s, NEG_INF)
        p = jax.nn.softmax(s, axis=-1)
        return jnp.einsum('bhqk,bkhd->bqhd', p.astype(v.dtype), v)

    o = lax.map(attend, (blocks(q_nope), blocks(q_rope), jnp.arange(nb) * Q_BLOCK))
    return o.swapaxes(0, 1).reshape(B, S, M_WIDTH)


def hybrid_layer(x, mod, norm_g, w_in, q_norm_g, w_uq, kv_norm_g, w_ukv, w_out_a, w_out_b, w_o, rel_bias, cos, sin):
    shift, scale, gate = jnp.split(mod, 3, axis=-1)
    h = rms_norm(x, norm_g) * (1 + scale[:, None]) + shift[:, None]
    a_qkv, a_z, m_cq, m_ckv, m_kr, m_z, merge = jnp.split(h @ w_in, SPLIT_IDX, axis=-1)
    y_a = dilated_mixer(a_qkv, rel_bias) * jax.nn.silu(a_z)
    y_m = mla_mixer(m_cq, m_ckv, m_kr, q_norm_g, w_uq, kv_norm_g, w_ukv, cos, sin) * jax.nn.silu(m_z)
    g_a, g_m = jnp.split(jax.nn.sigmoid(merge), 2, axis=-1)
    merged = g_a * (y_a @ w_out_a) + g_m * (y_m @ w_out_b)
    return x + gate[:, None] * (merged @ w_o)


def setup_inputs(seed: int = 0) -> dict:
    key = jax.random.key(seed)
    ks = jax.random.split(key, 16)
    n = jax.random.normal
    f32 = jnp.float32
    x = n(ks[0], (BATCH, SEQ, D_MODEL), f32)
    c = n(ks[1], (BATCH, D_MODEL), f32)
    positions = jnp.broadcast_to(jnp.arange(SEQ, dtype=jnp.int32)[None], (BATCH, SEQ))
    w_ada = n(ks[2], (DEPTH, D_MODEL, 3 * D_MODEL), f32) * (0.5 * D_MODEL ** -0.5)
    b_ada = n(ks[3], (DEPTH, 3 * D_MODEL), f32) * 0.01
    norm_g = 1.0 + 0.01 * n(ks[4], (DEPTH, D_MODEL), f32)
    w_in = n(ks[5], (DEPTH, D_MODEL, D_IN), f32) * D_MODEL ** -0.5
    q_norm_g = 1.0 + 0.01 * n(ks[6], (DEPTH, M_Q_LORA), f32)
    w_uq = n(ks[7], (DEPTH, M_Q_LORA, M_HEADS * (M_NOPE + M_ROPE)), f32) * M_Q_LORA ** -0.5
    kv_norm_g = 1.0 + 0.01 * n(ks[8], (DEPTH, M_KV_LORA), f32)
    w_ukv = n(ks[9], (DEPTH, M_KV_LORA, M_HEADS * (M_NOPE + M_V)), f32) * M_KV_LORA ** -0.5
    w_out_a = n(ks[10], (DEPTH, A_WIDTH, D_MODEL), f32) * A_WIDTH ** -0.5
    w_out_b = n(ks[11], (DEPTH, M_WIDTH, D_MODEL), f32) * M_WIDTH ** -0.5
    w_o = n(ks[12], (DEPTH, D_MODEL, D_MODEL), f32) * D_MODEL ** -0.5
    rel_bias = n(ks[13], (REL_BUCKETS, N_BIAS_HEADS), f32) * 0.5
    final_norm_g = 1.0 + 0.01 * n(ks[14], (D_MODEL,), f32)
    return {'x': x, 'c': c, 'positions': positions, 'w_ada': w_ada, 'b_ada': b_ada, 'norm_g': norm_g,
            'w_in': w_in, 'q_norm_g': q_norm_g, 'w_uq': w_uq, 'kv_norm_g': kv_norm_g, 'w_ukv': w_ukv,
            'w_out_a': w_out_a, 'w_out_b': w_out_b, 'w_o': w_o, 'rel_bias': rel_bias, 'final_norm_g': final_norm_g}


def reference(x, c, positions, w_ada, b_ada, norm_g, w_in, q_norm_g, w_uq, kv_norm_g, w_ukv,
              w_out_a, w_out_b, w_o, rel_bias, final_norm_g):
    inv_freq = 1.0 / (ROPE_THETA ** (jnp.arange(0, M_ROPE, 2, dtype=jnp.float32) / M_ROPE))
    ang = positions.astype(jnp.float32)[..., None] * inv_freq
    cos, sin = jnp.cos(ang), jnp.sin(ang)
    c_act = jax.nn.silu(c)
    for l in range(DEPTH):
        mod = c_act @ w_ada[l] + b_ada[l]
        x = hybrid_layer(x, mod, norm_g[l], w_in[l], q_norm_g[l], w_uq[l], kv_norm_g[l], w_ukv[l],
                         w_out_a[l], w_out_b[l], w_o[l], rel_bias, cos, sin)
    return rms_norm(x, final_norm_g)
```

```cpp
#include <hip/hip_runtime.h>
#include <hip/hip_cooperative_groups.h>
#include <cstdio>
#include <cstdint>
namespace cg = cooperative_groups;
#ifndef N_LAUNCH
#define N_LAUNCH 1
#endif
#ifndef PH
#define PH 63
#endif
namespace pg8 {
#define PG8_LAS __attribute__((address_space(3)))
typedef unsigned short bf16_t;
typedef short bf16x8 __attribute__((ext_vector_type(8)));
typedef float f32x4 __attribute__((ext_vector_type(4)));
typedef unsigned u32x4 __attribute__((ext_vector_type(4)));
constexpr int BM = 256, BK = 64, HALF = 128, HTB = HALF * BK * 2  , STAGE_BYTES = 8 * HTB, NXCD = 8, WGM = 8;

__host__ __device__ __forceinline__ int lds_byte(int r, int c) { const int st = (r >> 4) * 2 + (c >> 5), rr = r & 15, cc = c & 31, ob = rr * 64 + cc * 2; return st * 1024 + (ob ^ (((ob >> 9) & 1) << 5)); }
__host__ __device__ __forceinline__ void stage_rc(int b, int& R, int& C) { const int st = b / 1024, sb = b % 1024, swz = sb ^ (((sb >> 9) & 1) << 5); R = (st >> 1) * 16 + swz / 64; C = (st & 1) * 32 + (swz % 64) / 2; }
__host__ __device__ __forceinline__ int perm32(int rho) { const int n = rho >> 4, i = rho & 15; return 8 * (i >> 2) + 4 * n + (i & 3); }

struct Unit { int pm, pn; };
struct Gemm { const bf16_t* A; const bf16_t* Bt; int M, N, K; };

struct StaticOrder {
    int nM, nN, nwg, G, c;
    __host__ __device__ void init(int M, int N, int G_, int c_) { nM = M / BM; nN = N / BM; nwg = nM * nN; G = G_; c = c_; }
    __host__ __device__ bool next(int i, Unit& u) const {
        const long L = (long)i * G + c; if (L >= nwg) return false;
        int wgid = (int)L; { const int q = nwg / NXCD, r = nwg % NXCD, xcd = wgid % NXCD, off = wgid / NXCD; wgid = (xcd < r ? xcd * (q + 1) : r * (q + 1) + (xcd - r) * q) + off; }
        const int nig = WGM * nN, gid = wgid / nig, fm = gid * WGM, gsz = (nM - fm) < WGM ? (nM - fm) : WGM;
        u.pm = fm + ((wgid % nig) % gsz); u.pn = (wgid % nig) / gsz; return true;
    }
    __device__ __forceinline__ void a_ready(const Unit&) const {}
    __device__ __forceinline__ void done(const Unit&) const {}
};

__device__ __forceinline__ unsigned cvt_pk_bf16(float lo, float hi) { unsigned r; asm volatile("v_cvt_pk_bf16_f32 %0, %1, %2" : "=v"(r) : "v"(lo), "v"(hi)); return r; }
template <class Epi, class Sched, bool ALIGN_EPI = false, bool SP2 = false>
__device__ __forceinline__ void gemm_phase(PG8_LAS unsigned char* lds, const Gemm g, const Sched& S, const Epi& E) {
    int tid_ = threadIdx.x; asm volatile("" : "+v"(tid_));
    const int tid = tid_, wid = __builtin_amdgcn_readfirstlane(tid >> 6), lane = tid & 63, wr = wid >> 2, wc = wid & 3, fr = lane & 15, fq = lane >> 4;
    int K_ = g.K; asm volatile("" : "+s"(K_)); const int K = K_, nt = K / BK;
    unsigned voffA[2], voffB[2];
#pragma unroll
    for (int i = 0; i < 2; ++i) { int R, C; stage_rc(tid * 16 + i * 8192, R, C); const int Rb = Epi::PERM ? ((R & ~31) + perm32(R & 31)) : R;
        voffA[i] = (unsigned)(R * K + C) * 2u; voffB[i] = (unsigned)(Rb * K + C) * 2u; }
    const size_t kstep = (size_t)(BK * 2);
    const size_t hstep = (size_t)HALF * K * 2;
    const size_t tstep = 2 * hstep;
    const unsigned ldsw = (unsigned)wid * 1024u;
    const int aoff = lds_byte(wr * 64 + fr, fq * 8), boff = lds_byte(wc * 32 + fr, fq * 8);
#define PG8_SA(b, h) (((b) * 2 + (h)) * HTB)
#define PG8_SB(b, h) ((4 + (b) * 2 + (h)) * HTB)
#define PG8_STAGE(bufoff, gbase, voff) do { _Pragma("unroll") for (int _i = 0; _i < 2; ++_i) \
        __builtin_amdgcn_global_load_lds((const unsigned*)((const char*)(gbase) + (voff)[_i]), (PG8_LAS unsigned*)(lds + (bufoff) + ldsw + _i * 8192), 16, 0, 0); } while (0)
#define PG8_LDA(dst, b, h) do { _Pragma("unroll") for (int m = 0; m < 4; ++m) _Pragma("unroll") for (int k = 0; k < 2; ++k) dst[m][k] = *(const PG8_LAS bf16x8*)(lds + PG8_SA(b, h) + aoff + m * 2048 + k * 1024); } while (0)
#define PG8_LDB(dst, b, h) do { _Pragma("unroll") for (int n = 0; n < 2; ++n) _Pragma("unroll") for (int k = 0; k < 2; ++k) dst[n][k] = *(const PG8_LAS bf16x8*)(lds + PG8_SB(b, h) + boff + n * 2048 + k * 1024); } while (0)
#define PG8_MMA(ai, bj, At, Bt) do { __builtin_amdgcn_s_setprio(1); _Pragma("unroll") for (int m = 0; m < 4; ++m) _Pragma("unroll") for (int n = 0; n < 2; ++n) _Pragma("unroll") for (int k = 0; k < 2; ++k) \
        acc[ai][bj][m][n] = __builtin_amdgcn_mfma_f32_16x16x32_bf16(Bt[n][k], At[m][k], acc[ai][bj][m][n], 0, 0, 0); __builtin_amdgcn_s_setprio(0); } while (0)
#define PG8_WAIT_V(n) asm volatile("s_waitcnt vmcnt(" #n ")" ::: "memory")
#define PG8_WAIT_L(n) asm volatile("s_waitcnt lgkmcnt(" #n ")" ::: "memory")
#define PG8_BAR __builtin_amdgcn_s_barrier()
#define PG8_SCHED __builtin_amdgcn_sched_barrier(0)
    Unit cur, nxt; int ui = 0;
    if (!S.next(0, cur)) return;
    f32x4 acc[2][2][4][2];
#pragma unroll
    for (int a = 0; a < 2; ++a)
#pragma unroll
        for (int b = 0; b < 2; ++b)
#pragma unroll
            for (int m = 0; m < 4; ++m)
#pragma unroll
                for (int n = 0; n < 2; ++n) acc[a][b][m][n] = (f32x4){0.f, 0.f, 0.f, 0.f};
    bf16x8 At[4][2], B0[2][2], B1[2][2];
    const char* cA = (const char*)g.A + (size_t)cur.pm * tstep; const char* cB = (const char*)g.Bt + (size_t)cur.pn * tstep;
    S.a_ready(cur);
    if constexpr (SP2) {
        PG8_STAGE(PG8_SB(0, 0), cB, voffB); PG8_STAGE(PG8_SB(0, 1), cB + hstep, voffB); PG8_STAGE(PG8_SA(0, 0), cA, voffA); PG8_STAGE(PG8_SA(0, 1), cA + hstep, voffA);
        if (wr == 1) PG8_BAR;
        PG8_WAIT_V(2); PG8_BAR;
        PG8_STAGE(PG8_SB(1, 0), cB + kstep, voffB); PG8_STAGE(PG8_SA(1, 0), cA + kstep, voffA); PG8_STAGE(PG8_SB(1, 1), cB + hstep + kstep, voffB);
        PG8_WAIT_V(6); PG8_BAR;
    } else {
        PG8_STAGE(PG8_SB(0, 0), cB, voffB); PG8_STAGE(PG8_SA(0, 0), cA, voffA); PG8_STAGE(PG8_SB(0, 1), cB + hstep, voffB); PG8_STAGE(PG8_SA(0, 1), cA + hstep, voffA);
        if (wr == 1) PG8_BAR;
        PG8_WAIT_V(4); PG8_BAR;
        PG8_STAGE(PG8_SB(1, 0), cB + kstep, voffB); PG8_STAGE(PG8_SA(1, 0), cA + kstep, voffA); PG8_STAGE(PG8_SB(1, 1), cB + hstep + kstep, voffB);
        PG8_WAIT_V(6); PG8_BAR;
    }
    for (;;) {
        const bool has_next = S.next(ui + 1, nxt);
        const char* nA = has_next ? (const char*)g.A + (size_t)nxt.pm * tstep : cA; const char* nB = has_next ? (const char*)g.Bt + (size_t)nxt.pn * tstep : cB;
        for (int t = 0; t < nt; t += 2) {
            const bool last = (t == nt - 2);
            const char* a1 = cA + (size_t)(t + 1) * kstep;
            const char* a2 = last ? nA : cA + (size_t)(t + 2) * kstep; const char* b2 = last ? nB : cB + (size_t)(t + 2) * kstep;
            const char* a3 = a2 + kstep; const char* b3 = b2 + kstep;
            if (last && has_next) S.a_ready(nxt);
            if constexpr (SP2) {
            PG8_LDB(B0, 0, 0); PG8_LDB(B1, 0, 1); PG8_SCHED; PG8_LDA(At, 0, 0); PG8_STAGE(PG8_SA(1, 1), a1 + hstep, voffA);
            PG8_WAIT_V(8); PG8_WAIT_L(0); PG8_BAR; PG8_MMA(0, 0, At, B0); PG8_MMA(0, 1, At, B1); PG8_BAR; PG8_SCHED;
            PG8_LDA(At, 0, 1); PG8_STAGE(PG8_SB(0, 0), b2, voffB); PG8_STAGE(PG8_SB(0, 1), b2 + hstep, voffB); PG8_STAGE(PG8_SA(0, 0), a2, voffA);
            PG8_WAIT_V(8); PG8_WAIT_L(0); PG8_BAR; PG8_MMA(1, 0, At, B0); PG8_MMA(1, 1, At, B1); PG8_BAR; PG8_SCHED;
            PG8_LDB(B0, 1, 0); PG8_LDB(B1, 1, 1); PG8_SCHED; PG8_LDA(At, 1, 0); PG8_STAGE(PG8_SA(0, 1), a2 + hstep, voffA);
            PG8_WAIT_V(8); PG8_WAIT_L(0); PG8_BAR; PG8_MMA(0, 0, At, B0); PG8_MMA(0, 1, At, B1); PG8_BAR; PG8_SCHED;
            PG8_LDA(At, 1, 1); PG8_STAGE(PG8_SB(1, 0), b3, voffB); PG8_STAGE(PG8_SB(1, 1), b3 + hstep, voffB); PG8_STAGE(PG8_SA(1, 0), a3, voffA);
            PG8_WAIT_V(8); PG8_WAIT_L(0); PG8_BAR; PG8_MMA(1, 0, At, B0); PG8_MMA(1, 1, At, B1); PG8_BAR; PG8_SCHED;
            } else {
            PG8_LDB(B0, 0, 0); PG8_SCHED; PG8_LDA(At, 0, 0); PG8_STAGE(PG8_SA(1, 1), a1 + hstep, voffA);
            PG8_WAIT_L(8); PG8_BAR; PG8_WAIT_L(0); PG8_MMA(0, 0, At, B0); PG8_BAR; PG8_SCHED;
            PG8_LDB(B1, 0, 1); PG8_STAGE(PG8_SB(0, 0), b2, voffB);
            PG8_BAR; PG8_WAIT_L(0); PG8_MMA(0, 1, At, B1); PG8_BAR;
            PG8_LDA(At, 0, 1); PG8_STAGE(PG8_SA(0, 0), a2, voffA);
            PG8_BAR; PG8_WAIT_L(0); PG8_MMA(1, 0, At, B0); PG8_BAR; PG8_SCHED;
            PG8_STAGE(PG8_SB(0, 1), b2 + hstep, voffB);
            PG8_WAIT_V(6); PG8_BAR; PG8_MMA(1, 1, At, B1); PG8_BAR;
            PG8_LDB(B0, 1, 0); PG8_SCHED; PG8_LDA(At, 1, 0); PG8_STAGE(PG8_SA(0, 1), a2 + hstep, voffA);
            PG8_WAIT_L(8); PG8_BAR; PG8_WAIT_L(0); PG8_MMA(0, 0, At, B0); PG8_BAR; PG8_SCHED;
            PG8_LDB(B1, 1, 1); PG8_STAGE(PG8_SB(1, 0), b3, voffB);
            PG8_BAR; PG8_WAIT_L(0); PG8_MMA(0, 1, At, B1); PG8_BAR;
            PG8_LDA(At, 1, 1); PG8_STAGE(PG8_SA(1, 0), a3, voffA);
            PG8_BAR; PG8_WAIT_L(0); PG8_MMA(1, 0, At, B0); PG8_BAR; PG8_SCHED;
            PG8_STAGE(PG8_SB(1, 1), b3 + hstep, voffB);
            PG8_WAIT_V(6); PG8_BAR; PG8_MMA(1, 1, At, B1); PG8_BAR;
            }
        }
        if constexpr (ALIGN_EPI) { if (wr == 0) PG8_BAR; }
        if constexpr (!Epi::AFTER_DRAIN) { E(acc, cur, wr, wc, fr, fq); S.done(cur); }
        if (!has_next) break;
#pragma unroll
        for (int a = 0; a < 2; ++a)
#pragma unroll
            for (int b = 0; b < 2; ++b)
#pragma unroll
                for (int m = 0; m < 4; ++m)
#pragma unroll
                    for (int n = 0; n < 2; ++n) acc[a][b][m][n] = (f32x4){0.f, 0.f, 0.f, 0.f};
        cur = nxt; cA = nA; cB = nB; ++ui;
        if constexpr (ALIGN_EPI) { if (wr == 1) PG8_BAR; }
    }
    PG8_WAIT_V(0);
    if constexpr (!ALIGN_EPI) { if (wr == 0) PG8_BAR; }
    PG8_BAR;
    if constexpr (Epi::AFTER_DRAIN) { E.fused(acc, cur, wr, wc, fr, fq, lds, wid, lane); S.done(cur); }
#undef PG8_SA
#undef PG8_SB
#undef PG8_STAGE
#undef PG8_LDA
#undef PG8_LDB
#undef PG8_MMA
#undef PG8_WAIT_V
#undef PG8_WAIT_L
#undef PG8_BAR
#undef PG8_SCHED
}
}

#define LAS __attribute__((address_space(3)))
typedef unsigned short bf16_t;
typedef short bf16x8 __attribute__((ext_vector_type(8)));
typedef short s16x4 __attribute__((ext_vector_type(4)));
typedef float f32x4 __attribute__((ext_vector_type(4)));
typedef float f32x16 __attribute__((ext_vector_type(16)));
typedef unsigned u32x4 __attribute__((ext_vector_type(4)));
typedef unsigned u32x2 __attribute__((ext_vector_type(2)));

constexpr int SEQ = 16384, DM = 1024, DIN = 8608, NWAVES = 8;
constexpr float LOG2E = 1.4426950408889634f;
constexpr float EPS = 1e-6f;
constexpr float NEGB = -1e30f;
constexpr size_t MiB = 1u << 20;
constexpr size_t WS_WIN = 0;
constexpr size_t WS_WUQ = WS_WIN + (size_t)8704 * 1024 * 2;
constexpr size_t WS_WUKV = WS_WUQ + (size_t)1536 * 256 * 2;
constexpr size_t WS_WA = WS_WUKV + (size_t)2048 * 128 * 2;
constexpr size_t WS_WB = WS_WA + (size_t)1024 * 512 * 2;
constexpr size_t WS_WO = WS_WB + (size_t)1024 * 1024 * 2;
static_assert(WS_WO + (size_t)1024 * 1024 * 2 <= 24 * MiB, "weights region");
constexpr size_t WS_MOD = 24 * MiB;
constexpr size_t WS_BT = WS_MOD + 32768;
constexpr size_t WS_SSQ = WS_BT + 32768;
constexpr size_t WS_SSKV = WS_SSQ + (size_t)SEQ * 16;
constexpr size_t WS_COS = 25 * MiB;
constexpr size_t WS_SIN = 26 * MiB;
constexpr size_t WS_H = 27 * MiB;
constexpr size_t WS_ZA = WS_H + 32 * MiB;
constexpr size_t WS_ZM = WS_ZA + 16 * MiB;
constexpr size_t WS_CQ = WS_ZM + 32 * MiB;
constexpr size_t WS_CKV = WS_CQ + 8 * MiB;
constexpr size_t WS_KR = WS_CKV + 4 * MiB;
constexpr size_t WS_BIG = WS_KR + 1 * MiB;
constexpr size_t WS_END = WS_BIG + 144 * MiB;
constexpr size_t GSZ = (size_t)SEQ * 512;
constexpr int LDS_BYTES = 147456;
constexpr size_t WS_BAR = WS_MOD + 640 * 1024;
constexpr int LDS_ST = 139264;

__device__ __forceinline__ float fast_exp2(float x) { return __builtin_amdgcn_exp2f(x); }
__device__ __forceinline__ float fast_rcp(float x) { return __builtin_amdgcn_rcpf(x); }
__device__ __forceinline__ float silu_f(float v) { return v * fast_rcp(1.f + fast_exp2(-v * LOG2E)); }
__device__ __forceinline__ float sigm_f(float v) { return fast_rcp(1.f + fast_exp2(-v * LOG2E)); }
__device__ __forceinline__ float bf2f(unsigned short b) { return __uint_as_float((unsigned)b << 16); }
__device__ __forceinline__ float bflo(unsigned w) { return __uint_as_float(w << 16); }
__device__ __forceinline__ float bfhi(unsigned w) { return __uint_as_float(w & 0xffff0000u); }
using pg8::cvt_pk_bf16;
__device__ __forceinline__ u32x4 pack8(const f32x4& a, const f32x4& b) { u32x4 w; w.x = cvt_pk_bf16(a[0], a[1]); w.y = cvt_pk_bf16(a[2], a[3]); w.z = cvt_pk_bf16(b[0], b[1]); w.w = cvt_pk_bf16(b[2], b[3]); return w; }

struct EpiIn {
    static constexpr bool PERM = true, AFTER_DRAIN = false;
    bf16_t* BIG; bf16_t* ZA; bf16_t* ZM; bf16_t* CQ; bf16_t* CKV; bf16_t* KR; float* SSQ; float* SSKV; const float* COS; const float* SIN;
    __device__ __forceinline__ void operator()(const f32x4 (&acc)[2][2][4][2], const pg8::Unit& u, int wr, int wc, int fr, int fq) const {
        const int pn = u.pn; const int rowb = u.pm * 256 + wr * 64 + fr; const int cb = wc * 32 + 8 * fq;
        if (pn < 18) {
            const int which = pn / 6, g = (pn % 6) >> 1, half = pn & 1, sh = 2 * g;
            bf16_t* base = BIG + (size_t)(which * 3 + g) * GSZ + half * 256 + cb;
            const float sc = which == 0 ? 0.125f * LOG2E : 1.f;
#pragma unroll
            for (int ai = 0; ai < 2; ++ai)
#pragma unroll
                for (int m = 0; m < 4; ++m) { const int t = rowb + ai * 128 + m * 16; const int rho = (t & ((1 << sh) - 1)) * (SEQ >> sh) + (t >> sh);
#pragma unroll
                    for (int bj = 0; bj < 2; ++bj) *(u32x4*)(base + (size_t)rho * 512 + bj * 128) = pack8(acc[ai][bj][m][0] * sc, acc[ai][bj][m][1] * sc); }
        } else if (pn < 20 || pn >= 22) {
            bf16_t* base = pn < 20 ? ZA + (pn - 18) * 256 + cb : ZM + (pn - 22) * 256 + cb; const int ld = pn < 20 ? 512 : 1024;
#pragma unroll
            for (int ai = 0; ai < 2; ++ai)
#pragma unroll
                for (int m = 0; m < 4; ++m) { const int t = rowb + ai * 128 + m * 16;
#pragma unroll
                    for (int bj = 0; bj < 2; ++bj) { f32x4 a = acc[ai][bj][m][0], b = acc[ai][bj][m][1];
#pragma unroll
                        for (int j = 0; j < 4; ++j) { a[j] = silu_f(a[j]); b[j] = silu_f(b[j]); }
                        *(u32x4*)(base + (size_t)t * ld + bj * 128) = pack8(a, b); } }
        } else if (pn == 20) {
#pragma unroll
            for (int ai = 0; ai < 2; ++ai)
#pragma unroll
                for (int m = 0; m < 4; ++m) { const int t = rowb + ai * 128 + m * 16; float s = 0.f;
#pragma unroll
                    for (int bj = 0; bj < 2; ++bj) { const f32x4 a = acc[ai][bj][m][0], b = acc[ai][bj][m][1];
                        s += (a[0] * a[0] + a[1] * a[1]) + (a[2] * a[2] + a[3] * a[3]) + (b[0] * b[0] + b[1] * b[1]) + (b[2] * b[2] + b[3] * b[3]);
                        *(u32x4*)(CQ + (size_t)t * 256 + bj * 128 + cb) = pack8(a, b); }
                    s += __shfl_xor(s, 16); s += __shfl_xor(s, 32);
                    if (fq == 0) SSQ[(size_t)t * 4 + wc] = s; }
        } else {
#pragma unroll
            for (int ai = 0; ai < 2; ++ai)
#pragma unroll
                for (int m = 0; m < 4; ++m) { const int t = rowb + ai * 128 + m * 16;
                    const f32x4 a = acc[ai][0][m][0], b = acc[ai][0][m][1];
                    float s = (a[0] * a[0] + a[1] * a[1]) + (a[2] * a[2] + a[3] * a[3]) + (b[0] * b[0] + b[1] * b[1]) + (b[2] * b[2] + b[3] * b[3]);
                    *(u32x4*)(CKV + (size_t)t * 128 + cb) = pack8(a, b);
                    s += __shfl_xor(s, 16); s += __shfl_xor(s, 32);
                    if (fq == 0) SSKV[(size_t)t * 4 + wc] = s;
                    if (wc == 0) { const f32x4 t1 = acc[ai][1][m][0], t2 = acc[ai][1][m][1];
                        const f32x4 c = *(const f32x4*)(COS + (size_t)t * 16 + 4 * fq), sn = *(const f32x4*)(SIN + (size_t)t * 16 + 4 * fq);
                        const f32x4 o1 = t1 * c - t2 * sn, o2 = t1 * sn + t2 * c;
                        u32x2 w1, w2; w1.x = cvt_pk_bf16(o1[0], o1[1]); w1.y = cvt_pk_bf16(o1[2], o1[3]); w2.x = cvt_pk_bf16(o2[0], o2[1]); w2.y = cvt_pk_bf16(o2[2], o2[3]);
                        *(u32x2*)(KR + (size_t)t * 32 + 4 * fq) = w1; *(u32x2*)(KR + (size_t)t * 32 + 16 + 4 * fq) = w2; }
                    asm volatile("" ::: "memory"); }
        }
    }
};
struct EpiUq {
    static constexpr bool PERM = true, AFTER_DRAIN = false;
    bf16_t* Qm; const float* SSQ; const float* COS; const float* SIN;
    __device__ __forceinline__ void operator()(const f32x4 (&acc)[2][2][4][2], const pg8::Unit& u, int wr, int wc, int fr, int fq) const {
        const int pn = u.pn; const int rowb = u.pm * 256 + wr * 64 + fr;
        const float C2 = 0.10206207261596577f * LOG2E;
#pragma unroll
        for (int ai = 0; ai < 2; ++ai)
#pragma unroll
            for (int m = 0; m < 4; ++m) { const int t = rowb + ai * 128 + m * 16;
                const f32x4 ss = *(const f32x4*)(SSQ + (size_t)t * 4);
                const float f = __builtin_amdgcn_rsqf(((ss[0] + ss[1]) + (ss[2] + ss[3])) * (1.f / 256.f) + EPS) * C2;
                if (pn < 4) {
#pragma unroll
                    for (int bj = 0; bj < 2; ++bj) { const int gc = pn * 256 + bj * 128 + wc * 32 + 8 * fq;
                        *(u32x4*)(Qm + (size_t)t * 1536 + (gc >> 6) * 96 + (gc & 63)) = pack8(acc[ai][bj][m][0] * f, acc[ai][bj][m][1] * f); }
                } else {
                    const f32x4 c = *(const f32x4*)(COS + (size_t)t * 16 + 4 * fq), sn = *(const f32x4*)(SIN + (size_t)t * 16 + 4 * fq);
#pragma unroll
                    for (int bj = 0; bj < 2; ++bj) { const int head = (pn - 4) * 8 + bj * 4 + wc;
                        const f32x4 t1 = acc[ai][bj][m][0] * f, t2 = acc[ai][bj][m][1] * f;
                        const f32x4 o1 = t1 * c - t2 * sn, o2 = t1 * sn + t2 * c;
                        u32x2 w1, w2; w1.x = cvt_pk_bf16(o1[0], o1[1]); w1.y = cvt_pk_bf16(o1[2], o1[3]); w2.x = cvt_pk_bf16(o2[0], o2[1]); w2.y = cvt_pk_bf16(o2[2], o2[3]);
                        bf16_t* p = Qm + (size_t)t * 1536 + head * 96 + 64 + 4 * fq;
                        *(u32x2*)p = w1; *(u32x2*)(p + 16) = w2; }
                }
                asm volatile("" ::: "memory"); }
    }
};
struct EpiUkv {
    static constexpr bool PERM = true, AFTER_DRAIN = false;
    bf16_t* Km; bf16_t* Vm; const float* SSKV;
    __device__ __forceinline__ void operator()(const f32x4 (&acc)[2][2][4][2], const pg8::Unit& u, int wr, int wc, int fr, int fq) const {
        const int pn = u.pn; const int rowb = u.pm * 256 + wr * 64 + fr; const int cb = wc * 32 + 8 * fq;
        bf16_t* base = (pn < 4 ? Km + pn * 256 : Vm + (pn - 4) * 256) + cb;
#pragma unroll
        for (int ai = 0; ai < 2; ++ai)
#pragma unroll
            for (int m = 0; m < 4; ++m) { const int t = rowb + ai * 128 + m * 16;
                const f32x4 ss = *(const f32x4*)(SSKV + (size_t)t * 4);
                const float f = __builtin_amdgcn_rsqf(((ss[0] + ss[1]) + (ss[2] + ss[3])) * (1.f / 128.f) + EPS);
#pragma unroll
                for (int bj = 0; bj < 2; ++bj) *(u32x4*)(base + (size_t)t * 1024 + bj * 128) = pack8(acc[ai][bj][m][0] * f, acc[ai][bj][m][1] * f);
                asm volatile("" ::: "memory"); }
    }
};
struct EpiRes {
    static constexpr bool PERM = false, AFTER_DRAIN = false;
    const float* xin; float* out; const float* gate;
    __device__ __forceinline__ void operator()(const f32x4 (&acc)[2][2][4][2], const pg8::Unit& u, int wr, int wc, int fr, int fq) const {
        const int rowb = u.pm * 256 + wr * 64 + fr; const int c0 = u.pn * 256 + wc * 32 + 4 * fq;
        f32x4 gv[2][2];
#pragma unroll
        for (int bj = 0; bj < 2; ++bj)
#pragma unroll
            for (int n = 0; n < 2; ++n) gv[bj][n] = *(const f32x4*)(gate + c0 + bj * 128 + n * 16);
#pragma unroll
        for (int ai = 0; ai < 2; ++ai)
#pragma unroll
            for (int m = 0; m < 4; ++m) { const int t = rowb + ai * 128 + m * 16;
#pragma unroll
                for (int bj = 0; bj < 2; ++bj)
#pragma unroll
                    for (int n = 0; n < 2; ++n) { const size_t off = (size_t)t * 1024 + c0 + bj * 128 + n * 16;
                        const f32x4 xv = *(const f32x4*)(xin + off); *(f32x4*)(out + off) = xv + gv[bj][n] * acc[ai][bj][m][n]; }
                asm volatile("" ::: "memory"); }
    }
};


#define GEMM_PHASE(EPI, lds, g, S, E) pg8::gemm_phase<EPI, pg8::StaticOrder, true, true>(lds, g, S, E)


constexpr int P4_PITCH = 144, P4_OPB = 128 * P4_PITCH, P4_BUF = 2 * P4_OPB;
__device__ __forceinline__ void p4_pass(const bf16_t* __restrict__ A, int K, const bf16_t* __restrict__ B, int rt, int ct, f32x16& c0, f32x16& c1, LAS char* lds, int tid, int r32, int hi, int wa, int wb) {
    const bf16_t* asrc = A + (size_t)(rt * 128 + (tid >> 2)) * K + (tid & 3) * 8;
    const bf16_t* bsrc = B + (size_t)(ct * 128 + (tid >> 2)) * K + (tid & 3) * 8;
    const int sdst = (tid >> 2) * P4_PITCH + (tid & 3) * 16;
    const int xoff = (wa * 32 + r32) * P4_PITCH + hi * 16, woff = P4_OPB + (wb * 64 + r32) * P4_PITCH + hi * 16;
    const int nk = K >> 6;
    u32x4 ga0 = *(const u32x4*)asrc, ha0 = *(const u32x4*)(asrc + 32), gb0 = *(const u32x4*)bsrc, hb0 = *(const u32x4*)(bsrc + 32), ga1, ha1, gb1, hb1;
    *(LAS u32x4*)(lds + sdst) = ga0; *(LAS u32x4*)(lds + sdst + 64) = ha0; *(LAS u32x4*)(lds + P4_OPB + sdst) = gb0; *(LAS u32x4*)(lds + P4_OPB + sdst + 64) = hb0;
    ga1 = *(const u32x4*)(asrc + 64); ha1 = *(const u32x4*)(asrc + 96); gb1 = *(const u32x4*)(bsrc + 64); hb1 = *(const u32x4*)(bsrc + 96);
    __syncthreads();
    c0 = (f32x16){}; c1 = (f32x16){};
#define P4_STEP(kt, GA_LD, HA_LD, GB_LD, HB_LD, GA_ST, HA_ST, GB_ST, HB_ST) do { \
        const LAS char* buf = lds + ((kt) & 1) * P4_BUF; \
        if ((kt) + 2 < nk) { GA_LD = *(const u32x4*)(asrc + ((kt) + 2) * 64); HA_LD = *(const u32x4*)(asrc + ((kt) + 2) * 64 + 32); GB_LD = *(const u32x4*)(bsrc + ((kt) + 2) * 64); HB_LD = *(const u32x4*)(bsrc + ((kt) + 2) * 64 + 32); } \
        _Pragma("unroll") for (int s = 0; s < 4; ++s) { \
            const bf16x8 x = *(const LAS bf16x8*)(buf + xoff + s * 32); \
            const bf16x8 w0 = *(const LAS bf16x8*)(buf + woff + s * 32), w1 = *(const LAS bf16x8*)(buf + woff + 32 * P4_PITCH + s * 32); \
            c0 = __builtin_amdgcn_mfma_f32_32x32x16_bf16(w0, x, c0, 0, 0, 0); c1 = __builtin_amdgcn_mfma_f32_32x32x16_bf16(w1, x, c1, 0, 0, 0); } \
        if ((kt) + 1 < nk) { LAS char* nb = lds + (((kt) + 1) & 1) * P4_BUF; *(LAS u32x4*)(nb + sdst) = GA_ST; *(LAS u32x4*)(nb + sdst + 64) = HA_ST; *(LAS u32x4*)(nb + P4_OPB + sdst) = GB_ST; *(LAS u32x4*)(nb + P4_OPB + sdst + 64) = HB_ST; } \
        __syncthreads(); } while (0)
    for (int kt = 0; kt < nk; kt += 2) {
        P4_STEP(kt, ga0, ha0, gb0, hb0, ga1, ha1, gb1, hb1);
        P4_STEP(kt + 1, ga1, ha1, gb1, hb1, ga0, ha0, gb0, hb0);
    }
#undef P4_STEP
}
constexpr int P4_BUF2 = 3 * P4_OPB;
__device__ __forceinline__ void p4_pass2(const bf16_t* __restrict__ A, int K, const bf16_t* __restrict__ B0, const bf16_t* __restrict__ B1, int rt, int ct, f32x16& a0, f32x16& a1, f32x16& m0, f32x16& m1, LAS char* lds, int tid, int r32, int hi, int wa, int wb) {
    const bf16_t* asrc = A + (size_t)(rt * 128 + (tid >> 2)) * K + (tid & 3) * 8;
    const bf16_t* bsrc = B0 + (size_t)(ct * 128 + (tid >> 2)) * K + (tid & 3) * 8;
    const bf16_t* csrc = B1 + (size_t)(ct * 128 + (tid >> 2)) * K + (tid & 3) * 8;
    const int sdst = (tid >> 2) * P4_PITCH + (tid & 3) * 16;
    const int xoff = (wa * 32 + r32) * P4_PITCH + hi * 16, woff = P4_OPB + (wb * 64 + r32) * P4_PITCH + hi * 16;
    const int nk = K >> 6;
    u32x4 rA[6], rB[6];
#define P4_LD2(kt, R) do { R[0] = *(const u32x4*)(asrc + (kt) * 64); R[1] = *(const u32x4*)(asrc + (kt) * 64 + 32); R[2] = *(const u32x4*)(bsrc + (kt) * 64); R[3] = *(const u32x4*)(bsrc + (kt) * 64 + 32); \
        R[4] = *(const u32x4*)(csrc + (kt) * 64); R[5] = *(const u32x4*)(csrc + (kt) * 64 + 32); } while (0)
#define P4_ST2(boff, R) do { LAS char* nb_ = lds + (boff); *(LAS u32x4*)(nb_ + sdst) = R[0]; *(LAS u32x4*)(nb_ + sdst + 64) = R[1]; *(LAS u32x4*)(nb_ + P4_OPB + sdst) = R[2]; *(LAS u32x4*)(nb_ + P4_OPB + sdst + 64) = R[3]; \
        *(LAS u32x4*)(nb_ + 2 * P4_OPB + sdst) = R[4]; *(LAS u32x4*)(nb_ + 2 * P4_OPB + sdst + 64) = R[5]; } while (0)
    P4_LD2(0, rA); P4_ST2(0, rA); P4_LD2(1, rB);
    __syncthreads();
    a0 = (f32x16){}; a1 = (f32x16){}; m0 = (f32x16){}; m1 = (f32x16){};
#define P4_STEP2(kt, RL, RS) do { \
        const LAS char* buf = lds + ((kt) & 1) * P4_BUF2; \
        if ((kt) + 2 < nk) P4_LD2((kt) + 2, RL); \
        _Pragma("unroll") for (int s = 0; s < 4; ++s) { \
            const bf16x8 x = *(const LAS bf16x8*)(buf + xoff + s * 32); \
            const bf16x8 w0 = *(const LAS bf16x8*)(buf + woff + s * 32), w1 = *(const LAS bf16x8*)(buf + woff + 32 * P4_PITCH + s * 32); \
            const bf16x8 u0 = *(const LAS bf16x8*)(buf + P4_OPB + woff + s * 32), u1 = *(const LAS bf16x8*)(buf + P4_OPB + woff + 32 * P4_PITCH + s * 32); \
            a0 = __builtin_amdgcn_mfma_f32_32x32x16_bf16(w0, x, a0, 0, 0, 0); a1 = __builtin_amdgcn_mfma_f32_32x32x16_bf16(w1, x, a1, 0, 0, 0); \
            m0 = __builtin_amdgcn_mfma_f32_32x32x16_bf16(u0, x, m0, 0, 0, 0); m1 = __builtin_amdgcn_mfma_f32_32x32x16_bf16(u1, x, m1, 0, 0, 0); } \
        if ((kt) + 1 < nk) P4_ST2((((kt) + 1) & 1) * P4_BUF2, RS); \
        __syncthreads(); } while (0)
    for (int kt = 0; kt < nk; kt += 2) { P4_STEP2(kt, rA, rB); P4_STEP2(kt + 1, rB, rA); }
#undef P4_STEP2
#undef P4_LD2
#undef P4_ST2
}
__device__ __forceinline__ void p4_unit(int rt, int ct, const bf16_t* H, const bf16_t* YA, const bf16_t* YM, const bf16_t* Wga, const bf16_t* Wgm, const bf16_t* Wa, const bf16_t* Wb, bf16_t* MERGED, LAS char* lds) {
    int tid_ = threadIdx.x; asm volatile("" : "+v"(tid_)); const int tid = tid_, lane = tid & 63, r32 = lane & 31, hi = lane >> 5; const int wid = __builtin_amdgcn_readfirstlane(tid >> 6);
    const int wa = wid & 3, wb = wid >> 2;
    f32x16 g0, g1, m0, m1, c0, c1;
    p4_pass2(H, 1024, Wga, Wgm, rt, ct, g0, g1, m0, m1, lds, tid, r32, hi, wa, wb);
#pragma unroll
    for (int r = 0; r < 16; ++r) { g0[r] = sigm_f(g0[r]); g1[r] = sigm_f(g1[r]); m0[r] = sigm_f(m0[r]); m1[r] = sigm_f(m1[r]); }
    p4_pass(YA, 512, Wa, rt, ct, c0, c1, lds, tid, r32, hi, wa, wb);
    g0 *= c0; g1 *= c1;
    p4_pass(YM, 1024, Wb, rt, ct, c0, c1, lds, tid, r32, hi, wa, wb);
    g0 += m0 * c0; g1 += m1 * c1;
    bf16_t* op = MERGED + (size_t)(rt * 128 + wa * 32 + r32) * 1024 + ct * 128 + wb * 64 + 4 * hi;
#pragma unroll
    for (int g4 = 0; g4 < 4; ++g4) { u32x2 w; w.x = cvt_pk_bf16(g0[4 * g4], g0[4 * g4 + 1]); w.y = cvt_pk_bf16(g0[4 * g4 + 2], g0[4 * g4 + 3]); *(u32x2*)(op + 8 * g4) = w;
        u32x2 v; v.x = cvt_pk_bf16(g1[4 * g4], g1[4 * g4 + 1]); v.y = cvt_pk_bf16(g1[4 * g4 + 2], g1[4 * g4 + 3]); *(u32x2*)(op + 32 + 8 * g4) = v; }
}

__device__ __forceinline__ int crow(int r, int hi) { return (r & 3) + 8 * (r >> 2) + 4 * hi; }
__device__ __forceinline__ s16x4 vtr(const LAS char* p) { typedef short v4i16_t __attribute__((ext_vector_type(4))); return __builtin_bit_cast(s16x4, __builtin_amdgcn_ds_read_tr16_b64_v4i16((LAS v4i16_t*)p)); }
__device__ __forceinline__ bf16x8 cat8(s16x4 a, s16x4 b) { return (bf16x8){a[0], a[1], a[2], a[3], b[0], b[1], b[2], b[3]}; }
__device__ __forceinline__ bf16x8 packp(const f32x16& p, int b) { u32x4 w; w.x = cvt_pk_bf16(p[b], p[b + 1]); w.y = cvt_pk_bf16(p[b + 2], p[b + 3]); w.z = cvt_pk_bf16(p[b + 4], p[b + 5]); w.w = cvt_pk_bf16(p[b + 6], p[b + 7]); return __builtin_bit_cast(bf16x8, w); }
__device__ __forceinline__ float max3f(float a, float b, float c) { return fmaxf(fmaxf(a, b), c); }
__device__ __forceinline__ float max16(const f32x16& p) { float a = fmaxf(fmaxf(p[0], p[1]), fmaxf(p[2], p[3])), b = fmaxf(fmaxf(p[4], p[5]), fmaxf(p[6], p[7])), c = fmaxf(fmaxf(p[8], p[9]), fmaxf(p[10], p[11])), d = fmaxf(fmaxf(p[12], p[13]), fmaxf(p[14], p[15])); return fmaxf(fmaxf(a, b), fmaxf(c, d)); }

constexpr int KP = 208, VP = 192, KBUF = 64 * KP, VBUF = 64 * VP, STG = KBUF + VBUF;
__device__ __forceinline__ void mla_unit(int h, int qb, const bf16_t* __restrict__ Qm, const bf16_t* __restrict__ Km, const bf16_t* __restrict__ Kr, const bf16_t* __restrict__ Vm, bf16_t* ZM, LAS char* lds) {
    int tid_ = threadIdx.x; asm volatile("" : "+v"(tid_)); const int tid = tid_, lane = tid & 63, r32 = lane & 31, hi = lane >> 5; const int wid = __builtin_amdgcn_readfirstlane(tid >> 6);
    const int q0 = qb * 256, qrow = q0 + wid * 32 + r32;
    bf16x8 qf[6];
#pragma unroll
    for (int s = 0; s < 6; ++s) qf[s] = *(const bf16x8*)(Qm + (size_t)qrow * 1536 + h * 96 + 16 * s + 8 * hi);
    const int NT = (q0 + 256) / 64;
    const int srow = tid >> 3, sch = tid & 7, rrow = (tid & 255) >> 2, rch = tid & 3;
    const bf16_t* kn_src = Km + (size_t)srow * 1024 + h * 64 + sch * 8;
    const bf16_t* v_src = Vm + (size_t)srow * 1024 + h * 64 + sch * 8;
    const bf16_t* kr_src = Kr + (size_t)rrow * 32 + rch * 8;
    const int kn_dst = srow * KP + sch * 16, kr_dst = rrow * KP + 128 + rch * 16, v_dst = KBUF + srow * VP + sch * 16;
    u32x4 gknA, gkrA, gvA, gknB, gkrB, gvB;
    gknA = *(const u32x4*)kn_src; gvA = *(const u32x4*)v_src; gkrA = *(const u32x4*)kr_src;
    *(LAS u32x4*)(lds + kn_dst) = gknA; *(LAS u32x4*)(lds + v_dst) = gvA; if (tid < 256) *(LAS u32x4*)(lds + kr_dst) = gkrA;
    gknB = *(const u32x4*)(kn_src + (size_t)64 * 1024); gvB = *(const u32x4*)(v_src + (size_t)64 * 1024); gkrB = *(const u32x4*)(kr_src + (size_t)64 * 32);
    __syncthreads();
    float l = 0.f; f32x16 o0 = {}, o1 = {};
    const int ka_off = r32 * KP + hi * 16;
    const int i16 = lane & 15, dg = (lane >> 4) & 1;
    const int va_off = KBUF + (4 * hi + (i16 >> 2)) * VP + (16 * dg + 4 * (i16 & 3)) * 2;
    float mref = 0.f; f32x16 negm = {};
#define MLA_SB() __builtin_amdgcn_sched_barrier(0)
#define MLA_EX4(S, b) do { S[b] = fast_exp2(S[b]); S[b + 1] = fast_exp2(S[b + 1]); S[b + 2] = fast_exp2(S[b + 2]); S[b + 3] = fast_exp2(S[b + 3]); ps += (S[b] + S[b + 1]) + (S[b + 2] + S[b + 3]); } while (0)
#define MLA_STEP(t, GKN_LD, GV_LD, GKR_LD, GKN_ST, GV_ST, GKR_ST) do { \
        const LAS char* buf = lds + ((t) & 1) * STG; \
        if ((t) + 2 < NT) { const size_t o = (size_t)((t) + 2) * 64; GKN_LD = *(const u32x4*)(kn_src + o * 1024); GV_LD = *(const u32x4*)(v_src + o * 1024); GKR_LD = *(const u32x4*)(kr_src + o * 32); } \
        const int jb = (t) - (NT - 4); \
        if (!(jb >= 0 && 2 * jb > wid)) { \
              \
            bf16x8 ka[6], kb[6]; \
            _Pragma("unroll") for (int s = 0; s < 6; ++s) ka[s] = *(const LAS bf16x8*)(buf + ka_off + s * 32); \
            MLA_SB(); \
            _Pragma("unroll") for (int s = 0; s < 6; ++s) kb[s] = *(const LAS bf16x8*)(buf + ka_off + 32 * KP + s * 32); \
            MLA_SB(); \
            f32x16 s0 = negm, s1 = negm; float ps = 0.f; \
            __builtin_amdgcn_s_setprio(1); \
              \
            s0 = __builtin_amdgcn_mfma_f32_32x32x16_bf16(ka[0], qf[0], s0, 0, 0, 0); s1 = __builtin_amdgcn_mfma_f32_32x32x16_bf16(kb[0], qf[0], s1, 0, 0, 0); \
            s0 = __builtin_amdgcn_mfma_f32_32x32x16_bf16(ka[1], qf[1], s0, 0, 0, 0); s1 = __builtin_amdgcn_mfma_f32_32x32x16_bf16(kb[1], qf[1], s1, 0, 0, 0); \
            MLA_SB(); \
            const LAS char* vp0 = buf + va_off; \
            s16x4 v0[8]; \
            _Pragma("unroll") for (int ks = 0; ks < 2; ++ks) { v0[4 * ks] = vtr(vp0 + ks * 16 * VP); v0[4 * ks + 1] = vtr(vp0 + ks * 16 * VP + 8 * VP); v0[4 * ks + 2] = vtr(vp0 + ks * 16 * VP + 64); v0[4 * ks + 3] = vtr(vp0 + ks * 16 * VP + 8 * VP + 64); } \
            _Pragma("unroll") for (int s = 2; s < 6; ++s) s0 = __builtin_amdgcn_mfma_f32_32x32x16_bf16(ka[s], qf[s], s0, 0, 0, 0); \
            MLA_SB(); \
            if (jb >= 0) { _Pragma("unroll") for (int r = 0; r < 16; ++r) { const int kv = 64 * (t) + crow(r, hi); if (kv > qrow) s0[r] = NEGB; } } \
            float ra = max3f(s0[0], s0[1], s0[2]), ra2 = max3f(s0[3], s0[4], s0[5]); ra = max3f(ra, s0[6], s0[7]); ra2 = max3f(ra2, s0[8], s0[9]); ra = max3f(ra, s0[10], s0[11]); ra2 = max3f(ra2, s0[12], s0[13]); ra = max3f(ra, s0[14], s0[15]); ra = fmaxf(ra, ra2); \
            s1 = __builtin_amdgcn_mfma_f32_32x32x16_bf16(kb[2], qf[2], s1, 0, 0, 0); MLA_EX4(s0, 0); MLA_SB(); \
            s1 = __builtin_amdgcn_mfma_f32_32x32x16_bf16(kb[3], qf[3], s1, 0, 0, 0); MLA_EX4(s0, 4); MLA_SB(); \
            bf16x8 pb0, pb1; \
            s1 = __builtin_amdgcn_mfma_f32_32x32x16_bf16(kb[4], qf[4], s1, 0, 0, 0); MLA_EX4(s0, 8); pb0 = packp(s0, 0); MLA_SB(); \
            s1 = __builtin_amdgcn_mfma_f32_32x32x16_bf16(kb[5], qf[5], s1, 0, 0, 0); MLA_EX4(s0, 12); MLA_SB(); \
            pb1 = packp(s0, 8); \
            __builtin_amdgcn_s_setprio(0); \
            s16x4 v1[8];                                                       \
            _Pragma("unroll") for (int ks = 0; ks < 2; ++ks) { v1[4 * ks] = vtr(vp0 + (ks + 2) * 16 * VP); v1[4 * ks + 1] = vtr(vp0 + (ks + 2) * 16 * VP + 8 * VP); v1[4 * ks + 2] = vtr(vp0 + (ks + 2) * 16 * VP + 64); v1[4 * ks + 3] = vtr(vp0 + (ks + 2) * 16 * VP + 8 * VP + 64); } \
            MLA_SB(); \
            if (jb >= 0) { _Pragma("unroll") for (int r = 0; r < 16; ++r) { const int kv = 64 * (t) + crow(r, hi); if (kv + 32 > qrow) s1[r] = NEGB; } } \
            float rb = max3f(s1[0], s1[1], s1[2]), rb2 = max3f(s1[3], s1[4], s1[5]); rb = max3f(rb, s1[6], s1[7]); rb2 = max3f(rb2, s1[8], s1[9]); rb = max3f(rb, s1[10], s1[11]); rb2 = max3f(rb2, s1[12], s1[13]); rb = max3f(rb, s1[14], s1[15]); rb = max3f(rb, rb2, ra); \
            float rm = rb; { const auto rr_ = __builtin_amdgcn_permlane32_swap(__float_as_uint(rm), __float_as_uint(rm), false, false); rm = fmaxf(__uint_as_float(rr_[0]), __uint_as_float(rr_[1])); }     \
            if ((t) == 0 || __any(rm > 8.0f)) { \
                const float dl = (t) == 0 ? rm : fmaxf(rm, 0.f); mref += dl; const float f = fast_exp2(-dl); \
                _Pragma("unroll") for (int r = 0; r < 16; ++r) { s0[r] *= f; s1[r] -= dl; negm[r] = -mref; } \
                ps *= f; l *= f; o0 *= f; o1 *= f; pb0 = packp(s0, 0); pb1 = packp(s0, 8); } \
            MLA_SB(); \
            __builtin_amdgcn_s_setprio(1); \
            o0 = __builtin_amdgcn_mfma_f32_32x32x16_bf16(cat8(v0[0], v0[1]), pb0, o0, 0, 0, 0); MLA_EX4(s1, 0); MLA_SB(); \
            o1 = __builtin_amdgcn_mfma_f32_32x32x16_bf16(cat8(v0[2], v0[3]), pb0, o1, 0, 0, 0); MLA_EX4(s1, 4); MLA_SB(); \
            bf16x8 pb2; \
            o0 = __builtin_amdgcn_mfma_f32_32x32x16_bf16(cat8(v0[4], v0[5]), pb1, o0, 0, 0, 0); MLA_EX4(s1, 8); pb2 = packp(s1, 0); MLA_SB(); \
            o1 = __builtin_amdgcn_mfma_f32_32x32x16_bf16(cat8(v0[6], v0[7]), pb1, o1, 0, 0, 0); MLA_EX4(s1, 12); MLA_SB(); \
            l += ps; \
            const bf16x8 pb3 = packp(s1, 8); \
            MLA_SB(); \
            o0 = __builtin_amdgcn_mfma_f32_32x32x16_bf16(cat8(v1[0], v1[1]), pb2, o0, 0, 0, 0); o1 = __builtin_amdgcn_mfma_f32_32x32x16_bf16(cat8(v1[2], v1[3]), pb2, o1, 0, 0, 0); \
            o0 = __builtin_amdgcn_mfma_f32_32x32x16_bf16(cat8(v1[4], v1[5]), pb3, o0, 0, 0, 0); o1 = __builtin_amdgcn_mfma_f32_32x32x16_bf16(cat8(v1[6], v1[7]), pb3, o1, 0, 0, 0); \
            __builtin_amdgcn_s_setprio(0); \
            MLA_SB(); \
        } \
        if ((t) + 1 < NT) { LAS char* nb = lds + (((t) + 1) & 1) * STG; *(LAS u32x4*)(nb + kn_dst) = GKN_ST; *(LAS u32x4*)(nb + v_dst) = GV_ST; if (tid < 256) *(LAS u32x4*)(nb + kr_dst) = GKR_ST; } \
        __syncthreads(); } while (0)
    for (int t = 0; t < NT; t += 2) {
        MLA_STEP(t, gknA, gvA, gkrA, gknB, gvB, gkrB);
        MLA_STEP(t + 1, gknB, gvB, gkrB, gknA, gvA, gkrA);
    }
#undef MLA_STEP
#undef MLA_EX4
#undef MLA_SB
    l += __shfl_xor(l, 32); const float rl = fast_rcp(l);
    bf16_t* zp = ZM + (size_t)qrow * 1024 + h * 64 + 4 * hi;
#pragma unroll
    for (int db = 0; db < 2; ++db)
#pragma unroll
        for (int g4 = 0; g4 < 4; ++g4) { bf16_t* p = zp + 32 * db + 8 * g4; const u32x2 z = *(const u32x2*)p; const f32x16& o = db ? o1 : o0;
            u32x2 w; w.x = cvt_pk_bf16(o[4 * g4] * rl * bflo(z.x), o[4 * g4 + 1] * rl * bfhi(z.x)); w.y = cvt_pk_bf16(o[4 * g4 + 2] * rl * bflo(z.y), o[4 * g4 + 3] * rl * bfhi(z.y));
            *(u32x2*)p = w; }
}

constexpr int DL_V = 0, DL_LSE = 8 * 32 * VP, DL_TAB = DL_LSE + 3 * 512 * 4;
__device__ __forceinline__ void dil_unit(int hs, int un, bf16_t* BIG, bf16_t* ZA, const float* __restrict__ BT, LAS char* lds) {
    int tid_ = threadIdx.x; asm volatile("" : "+v"(tid_)); const int tid = tid_, lane = tid & 63, r32 = lane & 31, hi = lane >> 5; const int wid = __builtin_amdgcn_readfirstlane(tid >> 6);
    const int T0 = un * 512;
    LAS float* lse_l = (LAS float*)(lds + DL_LSE); LAS float* tab = (LAS float*)(lds + DL_TAB);
    for (int i = tid; i < 576; i += 512) tab[i] = BT[((i / 192) * 8 + hs) * 192 + (i % 192)];
    __syncthreads();
    LAS char* vst = lds + DL_V + wid * 32 * VP;
    const int i16 = lane & 15, dg = (lane >> 4) & 1;
    const int va_off = (4 * hi + (i16 >> 2)) * VP + (16 * dg + 4 * (i16 & 3)) * 2;
    for (int k = 0; k < 6; ++k) {
        const int item = wid + 8 * k, g = item >> 4, b = item & 15, sh = 2 * g, L = SEQ >> sh;
        const int p = b >> (4 - sh), sub = b & ((16 >> sh) - 1), m0 = (T0 >> sh) + 32 * sub;
        const size_t rowbase = (size_t)p * L;
        bf16_t* Qg = BIG + (size_t)(0 * 3 + g) * GSZ; const bf16_t* Kg = BIG + (size_t)(1 * 3 + g) * GSZ; const bf16_t* Vg = BIG + (size_t)(2 * 3 + g) * GSZ;
        const size_t qrow = rowbase + m0 + r32;
        bf16x8 qf[4];
#pragma unroll
        for (int s = 0; s < 4; ++s) qf[s] = *(const bf16x8*)(Qg + qrow * 512 + hs * 64 + 16 * s + 8 * hi);
        float mrun = NEGB, l = 0.f; f32x16 o0 = {}, o1 = {};
        const LAS float* tg = tab + g * 192;
        for (int c = 0; c < 5; ++c) {
            const int ks0 = m0 - 128 + 32 * c; if (ks0 < 0) continue;
            const bf16_t* kp = Kg + (rowbase + ks0 + r32) * 512 + hs * 64 + 8 * hi;
            bf16x8 ka[4];
#pragma unroll
            for (int s = 0; s < 4; ++s) ka[s] = *(const bf16x8*)(kp + 16 * s);
            u32x4 vv[4];
#pragma unroll
            for (int i = 0; i < 4; ++i) vv[i] = *(const u32x4*)(Vg + (rowbase + ks0 + (lane >> 3) + 8 * i) * 512 + hs * 64 + (lane & 7) * 8);
            f32x16 sc = {};
#pragma unroll
            for (int s = 0; s < 4; ++s) sc = __builtin_amdgcn_mfma_f32_32x32x16_bf16(ka[s], qf[s], sc, 0, 0, 0);
#pragma unroll
            for (int r = 0; r < 16; ++r) sc[r] += tg[160 - 32 * c + r32 - crow(r, hi)];
            float rm = max16(sc); rm = fmaxf(rm, __shfl_xor(rm, 32));
            const float mn = fmaxf(mrun, rm), alpha = fast_exp2(mrun - mn); mrun = mn;
            float ps = 0.f;
#pragma unroll
            for (int r = 0; r < 16; ++r) { sc[r] = fast_exp2(sc[r] - mn); ps += sc[r]; }
            l = l * alpha + ps; o0 *= alpha; o1 *= alpha;
            const bf16x8 pb0 = packp(sc, 0), pb1 = packp(sc, 8);
#pragma unroll
            for (int i = 0; i < 4; ++i) *(LAS u32x4*)(vst + ((lane >> 3) + 8 * i) * VP + (lane & 7) * 16) = vv[i];
            asm volatile("s_waitcnt lgkmcnt(0)" ::: "memory");
#pragma unroll
            for (int ks = 0; ks < 2; ++ks) { const bf16x8 pb = ks == 0 ? pb0 : pb1;
                const LAS char* vp = vst + va_off + ks * 16 * VP;
                const bf16x8 a0 = cat8(vtr(vp), vtr(vp + 8 * VP)), a1 = cat8(vtr(vp + 64), vtr(vp + 8 * VP + 64));
                o0 = __builtin_amdgcn_mfma_f32_32x32x16_bf16(a0, pb, o0, 0, 0, 0); o1 = __builtin_amdgcn_mfma_f32_32x32x16_bf16(a1, pb, o1, 0, 0, 0); }
            asm volatile("s_waitcnt lgkmcnt(0)" ::: "memory");
        }
        l += __shfl_xor(l, 32); const float rl = fast_rcp(l);
        if (hi == 0) lse_l[g * 512 + ((m0 + r32) << sh) + p - T0] = mrun + __builtin_amdgcn_logf(l);
        bf16_t* op = Qg + qrow * 512 + hs * 64 + 4 * hi;
#pragma unroll
        for (int db = 0; db < 2; ++db)
#pragma unroll
            for (int g4 = 0; g4 < 4; ++g4) { const f32x16& o = db ? o1 : o0;
                u32x2 w; w.x = cvt_pk_bf16(o[4 * g4] * rl, o[4 * g4 + 1] * rl); w.y = cvt_pk_bf16(o[4 * g4 + 2] * rl, o[4 * g4 + 3] * rl);
                *(u32x2*)(op + 32 * db + 8 * g4) = w; }
    }
    __syncthreads();
#pragma unroll 2
    for (int k = 0; k < 8; ++k) {
        const int piece = tid + 512 * k, tl = piece >> 3, ch = piece & 7, t = T0 + tl;
        const float l0 = lse_l[tl], l1 = lse_l[512 + tl], l2 = lse_l[1024 + tl];
        const float mx = fmaxf(l0, fmaxf(l1, l2));
        float w0 = fast_exp2(l0 - mx), w1 = fast_exp2(l1 - mx), w2 = fast_exp2(l2 - mx); const float rs = fast_rcp(w0 + w1 + w2); w0 *= rs; w1 *= rs; w2 *= rs;
        const u32x4 a = *(const u32x4*)(BIG + (size_t)t * 512 + hs * 64 + ch * 8);
        const u32x4 bq = *(const u32x4*)(BIG + GSZ + ((size_t)(t & 3) * (SEQ >> 2) + (t >> 2)) * 512 + hs * 64 + ch * 8);
        const u32x4 cq = *(const u32x4*)(BIG + 2 * GSZ + ((size_t)(t & 15) * (SEQ >> 4) + (t >> 4)) * 512 + hs * 64 + ch * 8);
        bf16_t* zp = ZA + (size_t)t * 512 + hs * 64 + ch * 8; const u32x4 z = *(const u32x4*)zp;
        u32x4 w;
#define CMB(f) w.f = cvt_pk_bf16((w0 * bflo(a.f) + w1 * bflo(bq.f) + w2 * bflo(cq.f)) * bflo(z.f), (w0 * bfhi(a.f) + w1 * bfhi(bq.f) + w2 * bfhi(cq.f)) * bfhi(z.f))
        CMB(x); CMB(y); CMB(z); CMB(w);
#undef CMB
        *(u32x4*)zp = w;
    }
    __syncthreads();
}


#define XB_TMO      128
#define XB_XCNT(j)  (256  + 64 * (j))
#define XB_XSUB(j)  (1280 + 64 * (j))
#define XB_XGEN(j)  (2304 + 64 * (j))
#define XB_TOP      3328
#define XB_TOPGEN   3392
#define XCD_BAR_WORDS 3456
#define XB_SPIN_CAP (1u << 18)

__device__ __forceinline__ unsigned xb_ld(unsigned* p)              { return __hip_atomic_load(p, __ATOMIC_RELAXED, __HIP_MEMORY_SCOPE_AGENT); }
__device__ __forceinline__ unsigned xb_add(unsigned* p, unsigned v) { return __hip_atomic_fetch_add(p, v, __ATOMIC_RELAXED, __HIP_MEMORY_SCOPE_AGENT); }
__device__ __forceinline__ unsigned xb_xcc_id() { return (unsigned)__builtin_amdgcn_s_getreg((3 << 11) | 20) & 0xFu; }
#define XB_SPIN(cond, bar) do { unsigned _sp = 0; while (cond) { __builtin_amdgcn_s_sleep(1); \
    if ((++_sp & 255u) == 0u) { if (xb_ld(&(bar)[XB_TMO])) break; if (_sp > XB_SPIN_CAP) { atomicAdd(&(bar)[XB_TMO], 1u); break; } } } } while (0)

struct XcdBarrier {
    unsigned* bar; unsigned x;
    volatile LAS unsigned* st;
};

__device__ __forceinline__ XcdBarrier xcd_barrier_post(unsigned* bar, volatile LAS unsigned* st) {
    XcdBarrier b; b.bar = bar; b.x = xb_xcc_id(); b.st = st;
    if (threadIdx.x == 0) (void)xb_add(&bar[XB_XCNT(b.x)], 1u);
    return b;
}
__device__ __forceinline__ void xcd_barrier_complete(unsigned* bar, unsigned x, unsigned& nloc, unsigned& nx) {
    const unsigned G = gridDim.x * gridDim.y * gridDim.z;
    unsigned sum, cnt, mine, sp = 0u;
    for (;;) {
        sum = 0u; cnt = 0u; mine = 0u;
#pragma unroll
        for (unsigned j = 0; j < 16; ++j) { const unsigned c = xb_ld(&bar[XB_XCNT(j)]); sum += c; cnt += (c > 0u) ? 1u : 0u; mine = (j == x) ? c : mine; }
        if (sum == G) break;
        __builtin_amdgcn_s_sleep(1);
        if ((++sp & 255u) == 0u) { if (xb_ld(&bar[XB_TMO])) break; if (sp > XB_SPIN_CAP) { atomicAdd(&bar[XB_TMO], 1u); break; } }
    }
    nloc = mine > 0u ? mine : 1u; nx = cnt > 0u ? cnt : 1u;
}

__device__ __forceinline__ void xcd_barrier(const XcdBarrier& b) {
    asm volatile("s_waitcnt vmcnt(0)" ::: "memory");
    __syncthreads();
    if (threadIdx.x == 0) {
        unsigned* bar = b.bar;
        __builtin_amdgcn_s_waitcnt(0);
        unsigned nloc = b.st[0], nx = b.st[1];
        if (nloc == 0u) { xcd_barrier_complete(bar, b.x, nloc, nx); b.st[0] = nloc; b.st[1] = nx; }
        const unsigned old = xb_add(&bar[XB_XSUB(b.x)], 1u);
        const unsigned gen = old / nloc;
        if (old + 1u == (gen + 1u) * nloc) {
            __builtin_amdgcn_fence(__ATOMIC_RELEASE, "agent");
            asm volatile("s_waitcnt vmcnt(0)" ::: "memory");
            const unsigned og = xb_add(&bar[XB_TOP], 1u);
            const unsigned tg = og / nx;
            if (og + 1u == (tg + 1u) * nx) xb_add(&bar[XB_TOPGEN], 1u);
            else XB_SPIN(xb_ld(&bar[XB_TOPGEN]) == tg, bar);
            __builtin_amdgcn_fence(__ATOMIC_ACQUIRE, "agent");
            xb_add(&bar[XB_XGEN(b.x)], 1u);
            asm volatile("s_waitcnt vmcnt(0)" ::: "memory");
        } else {
            XB_SPIN(xb_ld(&bar[XB_XGEN(b.x)]) == gen, bar);
            __builtin_amdgcn_fence(__ATOMIC_ACQUIRE, "agent");
            asm volatile("s_waitcnt vmcnt(0)" ::: "memory");
        }
    }
    __syncthreads();
}

__device__ __forceinline__ float wave_sum(float v) {
#pragma unroll
    for (int o = 1; o < 64; o <<= 1) v += __shfl_xor(v, o);
    return v;
}
__device__ __forceinline__ int rope_pos(int i) { return i < 16 ? 8 * (i >> 2) + (i & 3) : 8 * ((i - 16) >> 2) + 4 + (i & 3); }
__device__ __forceinline__ int dst_row(int mode, int n) {
    if (mode == 1) { if (n < 5504) return n; if (n < 5536) return 5504 + rope_pos(n - 5504); if (n < 6560) return 5632 + (n - 5536); return 6656 + (n - 6560); }
    if (mode == 2) { const int hd = n / 96, e = n - hd * 96; return e < 64 ? hd * 64 + e : 1024 + hd * 32 + rope_pos(e - 64); }
    if (mode == 3) { const int hd = n >> 7, e = n & 127; return e < 64 ? hd * 64 + e : 1024 + hd * 64 + (e - 64); }
    return n;
}
__device__ __forceinline__ void transpose_item(const float* __restrict__ W, int K, int N, bf16_t* WT, int mode, const float* __restrict__ kscale, LAS float* scr, int item, int lane) {
    const int nblk = N / 32, kb = item / nblk, nb = item % nblk, k0 = 64 * kb, n0 = 32 * nb;
#pragma unroll 8
    for (int i = 0; i < 32; ++i) { const int kk = 2 * i + (lane >> 5); float v = W[(size_t)(k0 + kk) * N + n0 + (lane & 31)]; if (kscale) v *= kscale[k0 + kk]; scr[kk * 33 + (lane & 31)] = v; }
    asm volatile("s_waitcnt lgkmcnt(0)" ::: "memory");
    const int c = lane & 7;
#pragma unroll
    for (int j = 0; j < 4; ++j) { const int n = (lane >> 3) + 8 * j; const LAS float* s = scr + (8 * c) * 33 + n;
        u32x4 o; o.x = cvt_pk_bf16(s[0 * 33], s[1 * 33]); o.y = cvt_pk_bf16(s[2 * 33], s[3 * 33]); o.z = cvt_pk_bf16(s[4 * 33], s[5 * 33]); o.w = cvt_pk_bf16(s[6 * 33], s[7 * 33]);
        *(u32x4*)(WT + (size_t)dst_row(mode, n0 + n) * K + k0 + 8 * c) = o; }
    asm volatile("s_waitcnt lgkmcnt(0)" ::: "memory");
}

struct Args { const float* in[16]; float* out; unsigned char* ws; int ph_lo, ph_hi; };
typedef const __attribute__((address_space(4))) Args* KArgs;

__device__ __forceinline__ void convert_weights(KArgs a, int layer, unsigned char* ws, LAS unsigned char* lds, int gw, int NGW, int wave, int lane) {
    LAS float* scr = (LAS float*)(lds + wave * 16384);
    const float* w_in = a->in[6] + (size_t)layer * DM * DIN; const float* w_uq = a->in[8] + (size_t)layer * 256 * 1536; const float* w_ukv = a->in[10] + (size_t)layer * 128 * 2048;
    const float* w_a = a->in[11] + (size_t)layer * 512 * 1024; const float* w_b = a->in[12] + (size_t)layer * 1024 * 1024; const float* w_o = a->in[13] + (size_t)layer * 1024 * 1024;
    const float* qg = a->in[7] + layer * 256; const float* kvg = a->in[9] + layer * 128;
    constexpr int I_IN = 16 * 269, I_UQ = 4 * 48, I_UKV = 2 * 64, I_A = 8 * 32, I_B = 16 * 32, I_O = 16 * 32, NIT = I_IN + I_UQ + I_UKV + I_A + I_B + I_O;
    for (int it = gw; it < NIT; it += NGW) {
        int r = it;
        if (r < I_IN) { transpose_item(w_in, 1024, DIN, (bf16_t*)(ws + WS_WIN), 1, nullptr, scr, r, lane); continue; } r -= I_IN;
        if (r < I_UQ) { transpose_item(w_uq, 256, 1536, (bf16_t*)(ws + WS_WUQ), 2, qg, scr, r, lane); continue; } r -= I_UQ;
        if (r < I_UKV) { transpose_item(w_ukv, 128, 2048, (bf16_t*)(ws + WS_WUKV), 3, kvg, scr, r, lane); continue; } r -= I_UKV;
        if (r < I_A) { transpose_item(w_a, 512, 1024, (bf16_t*)(ws + WS_WA), 0, nullptr, scr, r, lane); continue; } r -= I_A;
        if (r < I_B) { transpose_item(w_b, 1024, 1024, (bf16_t*)(ws + WS_WB), 0, nullptr, scr, r, lane); continue; } r -= I_B;
        transpose_item(w_o, 1024, 1024, (bf16_t*)(ws + WS_WO), 0, nullptr, scr, r, lane);
    }
}
__device__ __forceinline__ void adaln_rows(const float* x, const float* g, const float* mod, bf16_t* H, int gw, int NGW, int lane) {
    for (int m = gw; m < SEQ; m += NGW) {
        const f32x4* xr = (const f32x4*)(x + (size_t)m * DM) + lane; f32x4 v[4]; float s = 0.f;
#pragma unroll
        for (int j = 0; j < 4; ++j) { v[j] = xr[64 * j]; s += (v[j][0] * v[j][0] + v[j][1] * v[j][1]) + (v[j][2] * v[j][2] + v[j][3] * v[j][3]); }
        const float rstd = __builtin_amdgcn_rsqf(wave_sum(s) * (1.f / DM) + EPS);
        u32x2* o8 = (u32x2*)(H + (size_t)m * DM) + lane;
#pragma unroll
        for (int j = 0; j < 4; ++j) { const int c = 256 * j + 4 * lane; const f32x4 gg = *(const f32x4*)(g + c), sh = *(const f32x4*)(mod + c), sc = *(const f32x4*)(mod + 1024 + c);
            const f32x4 y = v[j] * rstd * gg * (sc + 1.f) + sh; u32x2 w; w.x = cvt_pk_bf16(y[0], y[1]); w.y = cvt_pk_bf16(y[2], y[3]); o8[64 * j] = w; }
    }
}
__device__ __forceinline__ void final_rows(float* x, const float* g, int gw, int NGW, int lane) {
    for (int m = gw; m < SEQ; m += NGW) {
        f32x4* xr = (f32x4*)(x + (size_t)m * DM) + lane; f32x4 v[4]; float s = 0.f;
#pragma unroll
        for (int j = 0; j < 4; ++j) { v[j] = xr[64 * j]; s += (v[j][0] * v[j][0] + v[j][1] * v[j][1]) + (v[j][2] * v[j][2] + v[j][3] * v[j][3]); }
        const float rstd = __builtin_amdgcn_rsqf(wave_sum(s) * (1.f / DM) + EPS);
#pragma unroll
        for (int j = 0; j < 4; ++j) { const f32x4 gg = *(const f32x4*)(g + 256 * j + 4 * lane); xr[64 * j] = v[j] * rstd * gg; }
    }
}

#define KARGS(name) KArgs name = (KArgs)__builtin_amdgcn_kernarg_segment_ptr(); asm volatile("" : "+s"(name))
#define GRID_SYNC() do { KARGS(kb_); XcdBarrier b_; b_.bar = (unsigned*)(kb_->ws + WS_BAR); b_.x = xb_xcc_id(); b_.st = (volatile LAS unsigned*)(lds + LDS_ST); xcd_barrier(b_); } while (0)
struct Ids { int G, bx, vcu; };
__device__ __forceinline__ Ids get_ids() { Ids r; r.G = gridDim.x; r.bx = blockIdx.x; r.vcu = (r.G % 8 == 0) ? (r.bx % 8) * (r.G / 8) + r.bx / 8 : r.bx; return r; }
#define FRESH_TID() int tid_ = threadIdx.x; asm volatile("" : "+v"(tid_)); const int tid = tid_, lane = tid & 63; const int wave = __builtin_amdgcn_readfirstlane(tid >> 6); (void)lane; (void)wave

__global__ void __launch_bounds__(NWAVES * 64, 2) fwd_mega(Args a_unused) {
    extern __shared__ __attribute__((aligned(16))) unsigned char lds_raw[];
    LAS unsigned char* lds = (LAS unsigned char*)lds_raw;
    int ph_lo, ph_hi; { KARGS(kp); ph_lo = kp->ph_lo; ph_hi = kp->ph_hi; }
    if (ph_lo < 0) cg::this_grid().sync();
    { KARGS(kb0); if (threadIdx.x < 2) ((LAS unsigned*)(lds + LDS_ST))[threadIdx.x] = 0u; __syncthreads(); (void)xcd_barrier_post((unsigned*)(kb0->ws + WS_BAR), (volatile LAS unsigned*)(lds + LDS_ST)); }
#define IN(k) (ph_lo <= (k) && (k) < ph_hi)
#define SEAM(k) do { if (IN(k) && IN((k) + 1)) GRID_SYNC(); } while (0)

    if (IN(0)) {
        KARGS(ka); FRESH_TID(); const Ids id = get_ids(); const int G = id.G, bx = id.bx;
        unsigned char* ws = ka->ws; const float* cvec = ka->in[1]; const int* pos = (const int*)ka->in[2]; const float* w_ada = ka->in[3]; const float* b_ada = ka->in[4]; const float* rel_bias = ka->in[14];
        float* MOD = (float*)(ws + WS_MOD); float* BT = (float*)(ws + WS_BT); float* COS = (float*)(ws + WS_COS); float* SIN = (float*)(ws + WS_SIN);
        LAS float* red = (LAS float*)(lds + 8 * 16384);
        for (int it = bx; it < 192; it += G) {
            const int l = it / 96, n0 = (it % 96) * 32, col = lane & 31, kh = lane >> 5; const float* wp = w_ada + (size_t)l * DM * 3072 + n0 + col; float s = 0.f;
            const int kbeg = wave * 128 + kh * 64;
#pragma unroll 16
            for (int k = 0; k < 64; ++k) { const float cv = cvec[kbeg + k]; s += silu_f(cv) * wp[(size_t)(kbeg + k) * 3072]; }
            red[wave * 64 + lane] = s; __syncthreads();
            if (tid < 32) { float t = b_ada[l * 3072 + n0 + tid]; for (int i = 0; i < 16; ++i) t += red[i * 32 + tid]; MOD[l * 3072 + n0 + tid] = t; }
            __syncthreads();
        }
        const int gt = id.vcu * 512 + tid, NGT = G * 512;
        for (int i = gt; i < 24 * 192; i += NGT) { const int gh = i / 192, idx = i % 192, g = gh >> 3, j = idx - 32; float v = NEGB;
            if (j >= 0 && j <= 128) { const int dist = j << (2 * g); int bucket;
                if (dist < 16) bucket = dist; else { bucket = 16 + (int)(logf((float)dist / 16.f) / 4.852030263919617f * 16.f); bucket = bucket < 31 ? bucket : 31; }
                v = rel_bias[bucket * 24 + gh] * LOG2E; }
            BT[i] = v; }
        for (int i = gt; i < SEQ * 16; i += NGT) { const int t = i >> 4, f = i & 15; const float inv = 1.0f / exp2f((float)f * (13.287712379549449f / 16.f));
            const float ang = (float)pos[t] * inv; double rev = (double)ang * 0.15915494309189535; rev -= floor(rev);
            COS[i] = __builtin_amdgcn_cosf((float)rev); SIN[i] = __builtin_amdgcn_sinf((float)rev); }
        convert_weights(ka, 0, ws, lds, id.vcu * NWAVES + wave, G * NWAVES, wave, lane);
    }
    SEAM(0);
#pragma unroll
    for (int layer = 0; layer < 2; ++layer) {
        const int pb = 1 + 7 * layer;
        if (IN(pb)) {
            KARGS(ka); FRESH_TID(); const Ids id = get_ids(); unsigned char* ws = ka->ws;
            if (layer == 1) convert_weights(ka, 1, ws, lds, id.vcu * NWAVES + wave, id.G * NWAVES, wave, lane);
            adaln_rows(layer == 0 ? ka->in[0] : (const float*)ka->out, ka->in[5] + layer * DM, (const float*)(ws + WS_MOD) + layer * 3072, (bf16_t*)(ws + WS_H), id.vcu * NWAVES + wave, id.G * NWAVES, lane);
        }
        SEAM(pb + 0);
#if PH&1
        if (IN(pb + 1))
        { KARGS(ka); const Ids id = get_ids(); unsigned char* ws = ka->ws;
          pg8::Gemm g{(const bf16_t*)(ws + WS_H), (const bf16_t*)(ws + WS_WIN), SEQ, 6656, 1024}; pg8::StaticOrder S; S.init(SEQ, 6656, id.G, id.bx);
          EpiIn E{(bf16_t*)(ws + WS_BIG), (bf16_t*)(ws + WS_ZA), (bf16_t*)(ws + WS_ZM), (bf16_t*)(ws + WS_CQ), (bf16_t*)(ws + WS_CKV), (bf16_t*)(ws + WS_KR), (float*)(ws + WS_SSQ), (float*)(ws + WS_SSKV), (const float*)(ws + WS_COS), (const float*)(ws + WS_SIN)};
          GEMM_PHASE(EpiIn, lds, g, S, E); }
#endif
        SEAM(pb + 1);
#if PH&2
        if (IN(pb + 2))
        { KARGS(ka); const Ids id = get_ids(); unsigned char* ws = ka->ws;
          for (int un = id.vcu; un < 256; un += id.G) dil_unit(un >> 5, un & 31, (bf16_t*)(ws + WS_BIG), (bf16_t*)(ws + WS_ZA), (const float*)(ws + WS_BT), (LAS char*)lds);
        }
#endif
        SEAM(pb + 2);
#if PH&4
        if (IN(pb + 3))
        { KARGS(ka); const Ids id = get_ids(); unsigned char* ws = ka->ws; bf16_t* Qm = (bf16_t*)(ws + WS_BIG);
          { pg8::Gemm g{(const bf16_t*)(ws + WS_CQ), (const bf16_t*)(ws + WS_WUQ), SEQ, 1536, 256}; pg8::StaticOrder S; S.init(SEQ, 1536, id.G, id.bx); EpiUq E{Qm, (const float*)(ws + WS_SSQ), (const float*)(ws + WS_COS), (const float*)(ws + WS_SIN)};
            GEMM_PHASE(EpiUq, lds, g, S, E); }
          { pg8::Gemm g{(const bf16_t*)(ws + WS_CKV), (const bf16_t*)(ws + WS_WUKV), SEQ, 2048, 128}; pg8::StaticOrder S; S.init(SEQ, 2048, id.G, id.bx); EpiUkv E{Qm + (size_t)SEQ * 1536, Qm + (size_t)SEQ * 2560, (const float*)(ws + WS_SSKV)};
            GEMM_PHASE(EpiUkv, lds, g, S, E); } }
#endif
        SEAM(pb + 3);
#if PH&8
        if (IN(pb + 4))
        { KARGS(ka); const Ids id = get_ids(); unsigned char* ws = ka->ws; const bf16_t* Qm = (const bf16_t*)(ws + WS_BIG);
          for (int i = 0; i < 4; ++i)
            for (int v = id.vcu; v < 256; v += id.G) { const int s = v & 15, hd = v >> 4; const int qb = i == 0 ? 63 - s : i == 1 ? 32 + s : i == 2 ? 31 - s : s;
                mla_unit(hd, qb, Qm, Qm + (size_t)SEQ * 1536, (const bf16_t*)(ws + WS_KR), Qm + (size_t)SEQ * 2560, (bf16_t*)(ws + WS_ZM), (LAS char*)lds); }
        }
#endif
        SEAM(pb + 4);
#if PH&16
        if (IN(pb + 5))
        { KARGS(ka); const Ids id = get_ids(); unsigned char* ws = ka->ws; bf16_t* MERGED = (bf16_t*)(ws + WS_BIG);
          const bf16_t* H = (const bf16_t*)(ws + WS_H); const bf16_t* WIN = (const bf16_t*)(ws + WS_WIN);
          for (int un = id.vcu; un < 1024; un += id.G) p4_unit(un >> 3, un & 7, H, (const bf16_t*)(ws + WS_ZA), (const bf16_t*)(ws + WS_ZM), WIN + (size_t)6656 * 1024, WIN + (size_t)7680 * 1024, (const bf16_t*)(ws + WS_WA), (const bf16_t*)(ws + WS_WB), MERGED, (LAS char*)lds); }
#endif
        SEAM(pb + 5);
#if PH&32
        if (IN(pb + 6))
        { KARGS(ka); const Ids id = get_ids(); unsigned char* ws = ka->ws;
          pg8::Gemm g{(const bf16_t*)(ws + WS_BIG), (const bf16_t*)(ws + WS_WO), SEQ, 1024, 1024}; pg8::StaticOrder S; S.init(SEQ, 1024, id.G, id.bx);
          EpiRes E{layer == 0 ? ka->in[0] : (const float*)ka->out, ka->out, (const float*)(ws + WS_MOD) + layer * 3072 + 2048};
          GEMM_PHASE(EpiRes, lds, g, S, E); }
#endif
        SEAM(pb + 6);
    }
    if (IN(15)) { KARGS(ka); FRESH_TID(); const Ids id = get_ids(); final_rows(ka->out, ka->in[15], id.vcu * NWAVES + wave, id.G * NWAVES, lane); }
}


extern "C" void kernel_launch(void* const* d_in, const int* in_sizes, int n_in, void* d_out, int out_size, void* d_ws, size_t ws_size, hipStream_t stream) {
    static int grid = 0;
    if (grid == 0) {
        if (n_in != 16 || out_size != SEQ * DM || ws_size < WS_END) { fprintf(stderr, "kernel_launch: unexpected problem: n_in %d out %d ws %zu (need %zu)\n", n_in, out_size, ws_size, (size_t)WS_END); grid = -1; return; }
        int dev = 0, cus = 0, per_cu = 0;
        if (hipGetDevice(&dev) != hipSuccess || hipDeviceGetAttribute(&cus, hipDeviceAttributeMultiprocessorCount, dev) != hipSuccess) { grid = -1; return; }
        if (hipFuncSetAttribute((const void*)fwd_mega, hipFuncAttributeMaxDynamicSharedMemorySize, LDS_BYTES) != hipSuccess) { fprintf(stderr, "kernel_launch: hipFuncSetAttribute failed\n"); grid = -1; return; }
        if (hipOccupancyMaxActiveBlocksPerMultiprocessor(&per_cu, (const void*)fwd_mega, NWAVES * 64, LDS_BYTES) != hipSuccess || per_cu < 1) fprintf(stderr, "kernel_launch: occupancy query says %d\n", per_cu);
        (void)hipGetLastError();
        grid = cus;
    }
    if (grid < 0) return;
    if (hipMemsetAsync((char*)d_ws + WS_BAR, 0, 16384, stream) != hipSuccess) { fprintf(stderr, "kernel_launch: memset failed\n"); return; }
    Args a{};
    for (int i = 0; i < 16; ++i) a.in[i] = (const float*)d_in[i];
    a.out = (float*)d_out; a.ws = (unsigned char*)d_ws;
#if N_LAUNCH == 1
    a.ph_lo = 0; a.ph_hi = 16;
    void* args[] = {&a};
    hipError_t e = hipLaunchCooperativeKernel((const void*)fwd_mega, dim3(grid), dim3(NWAVES * 64), args, LDS_BYTES, stream);
    if (e != hipSuccess) fprintf(stderr, "kernel_launch: cooperative launch failed: %s (grid %d)\n", hipGetErrorString(e), grid);
#else
    for (int p = 0; p < 16; ++p) { a.ph_lo = p; a.ph_hi = p + 1; hipLaunchKernelGGL(fwd_mega, dim3(grid), dim3(NWAVES * 64), LDS_BYTES, stream, a); }
#endif
}
```

```cpp
#include <hip/hip_runtime.h>
#include <hip/hip_cooperative_groups.h>
#include <cstdio>
#include <cstdint>
namespace cg = cooperative_groups;
#ifndef N_LAUNCH
#define N_LAUNCH 1
#endif
#ifndef PH
#define PH 63
#endif
namespace pg8 {
#define PG8_LAS __attribute__((address_space(3)))
typedef unsigned short bf16_t;
typedef short bf16x8 __attribute__((ext_vector_type(8)));
typedef float f32x4 __attribute__((ext_vector_type(4)));
typedef unsigned u32x4 __attribute__((ext_vector_type(4)));
constexpr int BM = 256, BK = 64, HALF = 128, HTB = HALF * BK * 2  , STAGE_BYTES = 8 * HTB, NXCD = 8, WGM = 8;

__host__ __device__ __forceinline__ int lds_byte(int r, int c) { const int st = (r >> 4) * 2 + (c >> 5), rr = r & 15, cc = c & 31, ob = rr * 64 + cc * 2; return st * 1024 + (ob ^ (((ob >> 9) & 1) << 5)); }
__host__ __device__ __forceinline__ void stage_rc(int b, int& R, int& C) { const int st = b / 1024, sb = b % 1024, swz = sb ^ (((sb >> 9) & 1) << 5); R = (st >> 1) * 16 + swz / 64; C = (st & 1) * 32 + (swz % 64) / 2; }
__host__ __device__ __forceinline__ int perm32(int rho) { const int n = rho >> 4, i = rho & 15; return 8 * (i >> 2) + 4 * n + (i & 3); }

struct Unit { int pm, pn; };
struct Gemm { const bf16_t* A; const bf16_t* Bt; int M, N, K; };

struct StaticOrder {
    int nM, nN, nwg, G, c;
    __host__ __device__ void init(int M, int N, int G_, int c_) { nM = M / BM; nN = N / BM; nwg = nM * nN; G = G_; c = c_; }
    __host__ __device__ bool next(int i, Unit& u) const {
        const long L = (long)i * G + c; if (L >= nwg) return false;
        int wgid = (int)L; { const int q = nwg / NXCD, r = nwg % NXCD, xcd = wgid % NXCD, off = wgid / NXCD; wgid = (xcd < r ? xcd * (q + 1) : r * (q + 1) + (xcd - r) * q) + off; }
        const int nig = WGM * nN, gid = wgid / nig, fm = gid * WGM, gsz = (nM - fm) < WGM ? (nM - fm) : WGM;
        u.pm = fm + ((wgid % nig) % gsz); u.pn = (wgid % nig) / gsz; return true;
    }
    __device__ __forceinline__ void a_ready(const Unit&) const {}
    __device__ __forceinline__ void done(const Unit&) const {}
};

__device__ __forceinline__ unsigned cvt_pk_bf16(float lo, float hi) { unsigned r; asm volatile("v_cvt_pk_bf16_f32 %0, %1, %2" : "=v"(r) : "v"(lo), "v"(hi)); return r; }
template <class Epi, class Sched, bool ALIGN_EPI = false, bool SP2 = false>
__device__ __forceinline__ void gemm_phase(PG8_LAS unsigned char* lds, const Gemm g, const Sched& S, const Epi& E) {
    int tid_ = threadIdx.x; asm volatile("" : "+v"(tid_));
    const int tid = tid_, wid = __builtin_amdgcn_readfirstlane(tid >> 6), lane = tid & 63, wr = wid >> 2, wc = wid & 3, fr = lane & 15, fq = lane >> 4;
    int K_ = g.K; asm volatile("" : "+s"(K_)); const int K = K_, nt = K / BK;
    unsigned voffA[2], voffB[2];
#pragma unroll
    for (int i = 0; i < 2; ++i) { int R, C; stage_rc(tid * 16 + i * 8192, R, C); const int Rb = Epi::PERM ? ((R & ~31) + perm32(R & 31)) : R;
        voffA[i] = (unsigned)(R * K + C) * 2u; voffB[i] = (unsigned)(Rb * K + C) * 2u; }
    const size_t kstep = (size_t)(BK * 2);
    const size_t hstep = (size_t)HALF * K * 2;
    const size_t tstep = 2 * hstep;
    const unsigned ldsw = (unsigned)wid * 1024u;
    const int aoff = lds_byte(wr * 64 + fr, fq * 8), boff = lds_byte(wc * 32 + fr, fq * 8);
#define PG8_SA(b, h) (((b) * 2 + (h)) * HTB)
#define PG8_SB(b, h) ((4 + (b) * 2 + (h)) * HTB)
#define PG8_STAGE(bufoff, gbase, voff) do { _Pragma("unroll") for (int _i = 0; _i < 2; ++_i) \
        __builtin_amdgcn_global_load_lds((const unsigned*)((const char*)(gbase) + (voff)[_i]), (PG8_LAS unsigned*)(lds + (bufoff) + ldsw + _i * 8192), 16, 0, 0); } while (0)
#define PG8_LDA(dst, b, h) do { _Pragma("unroll") for (int m = 0; m < 4; ++m) _Pragma("unroll") for (int k = 0; k < 2; ++k) dst[m][k] = *(const PG8_LAS bf16x8*)(lds + PG8_SA(b, h) + aoff + m * 2048 + k * 1024); } while (0)
#define PG8_LDB(dst, b, h) do { _Pragma("unroll") for (int n = 0; n < 2; ++n) _Pragma("unroll") for (int k = 0; k < 2; ++k) dst[n][k] = *(const PG8_LAS bf16x8*)(lds + PG8_SB(b, h) + boff + n * 2048 + k * 1024); } while (0)
#define PG8_MMA(ai, bj, At, Bt) do { __builtin_amdgcn_s_setprio(1); _Pragma("unroll") for (int m = 0; m < 4; ++m) _Pragma("unroll") for (int n = 0; n < 2; ++n) _Pragma("unroll") for (int k = 0; k < 2; ++k) \
        acc[ai][bj][m][n] = __builtin_amdgcn_mfma_f32_16x16x32_bf16(Bt[n][k], At[m][k], acc[ai][bj][m][n], 0, 0, 0); __builtin_amdgcn_s_setprio(0); } while (0)
#define PG8_WAIT_V(n) asm volatile("s_waitcnt vmcnt(" #n ")" ::: "memory")
#define PG8_WAIT_L(n) asm volatile("s_waitcnt lgkmcnt(" #n ")" ::: "memory")
#define PG8_BAR __builtin_amdgcn_s_barrier()
#define PG8_SCHED __builtin_amdgcn_sched_barrier(0)
    Unit cur, nxt; int ui = 0;
    if (!S.next(0, cur)) return;
    f32x4 acc[2][2][4][2];
#pragma unroll
    for (int a = 0; a < 2; ++a)
#pragma unroll
        for (int b = 0; b < 2; ++b)
#pragma unroll
            for (int m = 0; m < 4; ++m)
#pragma unroll
                for (int n = 0; n < 2; ++n) acc[a][b][m][n] = (f32x4){0.f, 0.f, 0.f, 0.f};
    bf16x8 At[4][2], B0[2][2], B1[2][2];
    const char* cA = (const char*)g.A + (size_t)cur.pm * tstep; const char* cB = (const char*)g.Bt + (size_t)cur.pn * tstep;
    S.a_ready(cur);
    if constexpr (SP2) {
        PG8_STAGE(PG8_SB(0, 0), cB, voffB); PG8_STAGE(PG8_SB(0, 1), cB + hstep, voffB); PG8_STAGE(PG8_SA(0, 0), cA, voffA); PG8_STAGE(PG8_SA(0, 1), cA + hstep, voffA);
        if (wr == 1) PG8_BAR;
        PG8_WAIT_V(2); PG8_BAR;
        PG8_STAGE(PG8_SB(1, 0), cB + kstep, voffB); PG8_STAGE(PG8_SA(1, 0), cA + kstep, voffA); PG8_STAGE(PG8_SB(1, 1), cB + hstep + kstep, voffB);
        PG8_WAIT_V(6); PG8_BAR;
    } else {
        PG8_STAGE(PG8_SB(0, 0), cB, voffB); PG8_STAGE(PG8_SA(0, 0), cA, voffA); PG8_STAGE(PG8_SB(0, 1), cB + hstep, voffB); PG8_STAGE(PG8_SA(0, 1), cA + hstep, voffA);
        if (wr == 1) PG8_BAR;
        PG8_WAIT_V(4); PG8_BAR;
        PG8_STAGE(PG8_SB(1, 0), cB + kstep, voffB); PG8_STAGE(PG8_SA(1, 0), cA + kstep, voffA); PG8_STAGE(PG8_SB(1, 1), cB + hstep + kstep, voffB);
        PG8_WAIT_V(6); PG8_BAR;
    }
    for (;;) {
        const bool has_next = S.next(ui + 1, nxt);
        const char* nA = has_next ? (const char*)g.A + (size_t)nxt.pm * tstep : cA; const char* nB = has_next ? (const char*)g.Bt + (size_t)nxt.pn * tstep : cB;
        for (int t = 0; t < nt; t += 2) {
            const bool last = (t == nt - 2);
            const char* a1 = cA + (size_t)(t + 1) * kstep;
            const char* a2 = last ? nA : cA + (size_t)(t + 2) * kstep; const char* b2 = last ? nB : cB + (size_t)(t + 2) * kstep;
            const char* a3 = a2 + kstep; const char* b3 = b2 + kstep;
            if (last && has_next) S.a_ready(nxt);
            if constexpr (SP2) {
            PG8_LDB(B0, 0, 0); PG8_LDB(B1, 0, 1); PG8_SCHED; PG8_LDA(At, 0, 0); PG8_STAGE(PG8_SA(1, 1), a1 + hstep, voffA);
            PG8_WAIT_V(8); PG8_WAIT_L(0); PG8_BAR; PG8_MMA(0, 0, At, B0); PG8_MMA(0, 1, At, B1); PG8_BAR; PG8_SCHED;
            PG8_LDA(At, 0, 1); PG8_STAGE(PG8_SB(0, 0), b2, voffB); PG8_STAGE(PG8_SB(0, 1), b2 + hstep, voffB); PG8_STAGE(PG8_SA(0, 0), a2, voffA);
            PG8_WAIT_V(8); PG8_WAIT_L(0); PG8_BAR; PG8_MMA(1, 0, At, B0); PG8_MMA(1, 1, At, B1); PG8_BAR; PG8_SCHED;
            PG8_LDB(B0, 1, 0); PG8_LDB(B1, 1, 1); PG8_SCHED; PG8_LDA(At, 1, 0); PG8_STAGE(PG8_SA(0, 1), a2 + hstep, voffA);
            PG8_WAIT_V(8); PG8_WAIT_L(0); PG8_BAR; PG8_MMA(0, 0, At, B0); PG8_MMA(0, 1, At, B1); PG8_BAR; PG8_SCHED;
            PG8_LDA(At, 1, 1); PG8_STAGE(PG8_SB(1, 0), b3, voffB); PG8_STAGE(PG8_SB(1, 1), b3 + hstep, voffB); PG8_STAGE(PG8_SA(1, 0), a3, voffA);
            PG8_WAIT_V(8); PG8_WAIT_L(0); PG8_BAR; PG8_MMA(1, 0, At, B0); PG8_MMA(1, 1, At, B1); PG8_BAR; PG8_SCHED;
            } else {
            PG8_LDB(B0, 0, 0); PG8_SCHED; PG8_LDA(At, 0, 0); PG8_STAGE(PG8_SA(1, 1), a1 + hstep, voffA);
            PG8_WAIT_L(8); PG8_BAR; PG8_WAIT_L(0); PG8_MMA(0, 0, At, B0); PG8_BAR; PG8_SCHED;
            PG8_LDB(B1, 0, 1); PG8_STAGE(PG8_SB(0, 0), b2, voffB);
            PG8_BAR; PG8_WAIT_L(0); PG8_MMA(0, 1, At, B1); PG8_BAR;
            PG8_LDA(At, 0, 1); PG8_STAGE(PG8_SA(0, 0), a2, voffA);
            PG8_BAR; PG8_WAIT_L(0); PG8_MMA(1, 0, At, B0); PG8_BAR; PG8_SCHED;
            PG8_STAGE(PG8_SB(0, 1), b2 + hstep, voffB);
            PG8_WAIT_V(6); PG8_BAR; PG8_MMA(1, 1, At, B1); PG8_BAR;
            PG8_LDB(B0, 1, 0); PG8_SCHED; PG8_LDA(At, 1, 0); PG8_STAGE(PG8_SA(0, 1), a2 + hstep, voffA);
            PG8_WAIT_L(8); PG8_BAR; PG8_WAIT_L(0); PG8_MMA(0, 0, At, B0); PG8_BAR; PG8_SCHED;
            PG8_LDB(B1, 1, 1); PG8_STAGE(PG8_SB(1, 0), b3, voffB);
            PG8_BAR; PG8_WAIT_L(0); PG8_MMA(0, 1, At, B1); PG8_BAR;
            PG8_LDA(At, 1, 1); PG8_STAGE(PG8_SA(1, 0), a3, voffA);
            PG8_BAR; PG8_WAIT_L(0); PG8_MMA(1, 0, At, B0); PG8_BAR; PG8_SCHED;
            PG8_STAGE(PG8_SB(1, 1), b3 + hstep, voffB);
            PG8_WAIT_V(6); PG8_BAR; PG8_MMA(1, 1, At, B1); PG8_BAR;
            }
        }
        if constexpr (ALIGN_EPI) { if (wr == 0) PG8_BAR; }
        if constexpr (!Epi::AFTER_DRAIN) { E(acc, cur, wr, wc, fr, fq); S.done(cur); }
        if (!has_next) break;
#pragma unroll
        for (int a = 0; a < 2; ++a)
#pragma unroll
            for (int b = 0; b < 2; ++b)
#pragma unroll
                for (int m = 0; m < 4; ++m)
#pragma unroll
                    for (int n = 0; n < 2; ++n) acc[a][b][m][n] = (f32x4){0.f, 0.f, 0.f, 0.f};
        cur = nxt; cA = nA; cB = nB; ++ui;
        if constexpr (ALIGN_EPI) { if (wr == 1) PG8_BAR; }
    }
    PG8_WAIT_V(0);
    if constexpr (!ALIGN_EPI) { if (wr == 0) PG8_BAR; }
    PG8_BAR;
    if constexpr (Epi::AFTER_DRAIN) { E.fused(acc, cur, wr, wc, fr, fq, lds, wid, lane); S.done(cur); }
#undef PG8_SA
#undef PG8_SB
#undef PG8_STAGE
#undef PG8_LDA
#undef PG8_LDB
#undef PG8_MMA
#undef PG8_WAIT_V
#undef PG8_WAIT_L
#undef PG8_BAR
#undef PG8_SCHED
}
}

#define LAS __attribute__((address_space(3)))
typedef unsigned short bf16_t;
typedef short bf16x8 __attribute__((ext_vector_type(8)));
typedef short s16x4 __attribute__((ext_vector_type(4)));
typedef float f32x4 __attribute__((ext_vector_type(4)));
typedef float f32x16 __attribute__((ext_vector_type(16)));
typedef unsigned u32x4 __attribute__((ext_vector_type(4)));
typedef unsigned u32x2 __attribute__((ext_vector_type(2)));

constexpr int SEQ = 16384, DM = 1024, DIN = 8608, NWAVES = 8;
constexpr float LOG2E = 1.4426950408889634f;
constexpr float EPS = 1e-6f;
constexpr float NEGB = -1e30f;
constexpr size_t MiB = 1u << 20;
constexpr size_t WS_WIN = 0;
constexpr size_t WS_WUQ = WS_WIN + (size_t)8704 * 1024 * 2;
constexpr size_t WS_WUKV = WS_WUQ + (size_t)1536 * 256 * 2;
constexpr size_t WS_WA = WS_WUKV + (size_t)2048 * 128 * 2;
constexpr size_t WS_WB = WS_WA + (size_t)1024 * 512 * 2;
constexpr size_t WS_WO = WS_WB + (size_t)1024 * 1024 * 2;
static_assert(WS_WO + (size_t)1024 * 1024 * 2 <= 24 * MiB, "weights region");
constexpr size_t WS_MOD = 24 * MiB;
constexpr size_t WS_BT = WS_MOD + 32768;
constexpr size_t WS_SSQ = WS_BT + 32768;
constexpr size_t WS_SSKV = WS_SSQ + (size_t)SEQ * 16;
constexpr size_t WS_COS = 25 * MiB;
constexpr size_t WS_SIN = 26 * MiB;
constexpr size_t WS_H = 27 * MiB;
constexpr size_t WS_ZA = WS_H + 32 * MiB;
constexpr size_t WS_ZM = WS_ZA + 16 * MiB;
constexpr size_t WS_CQ = WS_ZM + 32 * MiB;
constexpr size_t WS_CKV = WS_CQ + 8 * MiB;
constexpr size_t WS_KR = WS_CKV + 4 * MiB;
constexpr size_t WS_BIG = WS_KR + 1 * MiB;
constexpr size_t WS_END = WS_BIG + 144 * MiB;
constexpr size_t GSZ = (size_t)SEQ * 512;
constexpr int LDS_BYTES = 147456;
constexpr size_t WS_BAR = WS_MOD + 640 * 1024;
constexpr int LDS_ST = 139264;

__device__ __forceinline__ float fast_exp2(float x) { return __builtin_amdgcn_exp2f(x); }
__device__ __forceinline__ float fast_rcp(float x) { return __builtin_amdgcn_rcpf(x); }
__device__ __forceinline__ float silu_f(float v) { return v * fast_rcp(1.f + fast_exp2(-v * LOG2E)); }
__device__ __forceinline__ float sigm_f(float v) { return fast_rcp(1.f + fast_exp2(-v * LOG2E)); }
__device__ __forceinline__ float bf2f(unsigned short b) { return __uint_as_float((unsigned)b << 16); }
__device__ __forceinline__ float bflo(unsigned w) { return __uint_as_float(w << 16); }
__device__ __forceinline__ float bfhi(unsigned w) { return __uint_as_float(w & 0xffff0000u); }
using pg8::cvt_pk_bf16;
__device__ __forceinline__ u32x4 pack8(const f32x4& a, const f32x4& b) { u32x4 w; w.x = cvt_pk_bf16(a[0], a[1]); w.y = cvt_pk_bf16(a[2], a[3]); w.z = cvt_pk_bf16(b[0], b[1]); w.w = cvt_pk_bf16(b[2], b[3]); return w; }

struct EpiIn {
    static constexpr bool PERM = true, AFTER_DRAIN = false;
    bf16_t* BIG; bf16_t* ZA; bf16_t* ZM; bf16_t* CQ; bf16_t* CKV; bf16_t* KR; float* SSQ; float* SSKV; const float* COS; const float* SIN;
    __device__ __forceinline__ void operator()(const f32x4 (&acc)[2][2][4][2], const pg8::Unit& u, int wr, int wc, int fr, int fq) const {
        const int pn = u.pn; const int rowb = u.pm * 256 + wr * 64 + fr; const int cb = wc * 32 + 8 * fq;
        if (pn < 18) {
            const int which = pn / 6, g = (pn % 6) >> 1, half = pn & 1, sh = 2 * g;
            bf16_t* base = BIG + (size_t)(which * 3 + g) * GSZ + half * 256 + cb;
            const float sc = which == 0 ? 0.125f * LOG2E : 1.f;
#pragma unroll
            for (int ai = 0; ai < 2; ++ai)
#pragma unroll
                for (int m = 0; m < 4; ++m) { const int t = rowb + ai * 128 + m * 16; const int rho = (t & ((1 << sh) - 1)) * (SEQ >> sh) + (t >> sh);
#pragma unroll
                    for (int bj = 0; bj < 2; ++bj) *(u32x4*)(base + (size_t)rho * 512 + bj * 128) = pack8(acc[ai][bj][m][0] * sc, acc[ai][bj][m][1] * sc); }
        } else if (pn < 20 || pn >= 22) {
            bf16_t* base = pn < 20 ? ZA + (pn - 18) * 256 + cb : ZM + (pn - 22) * 256 + cb; const int ld = pn < 20 ? 512 : 1024;
#pragma unroll
            for (int ai = 0; ai < 2; ++ai)
#pragma unroll
                for (int m = 0; m < 4; ++m) { const int t = rowb + ai * 128 + m * 16;
#pragma unroll
                    for (int bj = 0; bj < 2; ++bj) { f32x4 a = acc[ai][bj][m][0], b = acc[ai][bj][m][1];
#pragma unroll
                        for (int j = 0; j < 4; ++j) { a[j] = silu_f(a[j]); b[j] = silu_f(b[j]); }
                        *(u32x4*)(base + (size_t)t * ld + bj * 128) = pack8(a, b); } }
        } else if (pn == 20) {
#pragma unroll
            for (int ai = 0; ai < 2; ++ai)
#pragma unroll
                for (int m = 0; m < 4; ++m) { const int t = rowb + ai * 128 + m * 16; float s = 0.f;
#pragma unroll
                    for (int bj = 0; bj < 2; ++bj) { const f32x4 a = acc[ai][bj][m][0], b = acc[ai][bj][m][1];
                        s += (a[0] * a[0] + a[1] * a[1]) + (a[2] * a[2] + a[3] * a[3]) + (b[0] * b[0] + b[1] * b[1]) + (b[2] * b[2] + b[3] * b[3]);
                        *(u32x4*)(CQ + (size_t)t * 256 + bj * 128 + cb) = pack8(a, b); }
                    s += __shfl_xor(s, 16); s += __shfl_xor(s, 32);
                    if (fq == 0) SSQ[(size_t)t * 4 + wc] = s; }
        } else {
#pragma unroll
            for (int ai = 0; ai < 2; ++ai)
#pragma unroll
                for (int m = 0; m < 4; ++m) { const int t = rowb + ai * 128 + m * 16;
                    const f32x4 a = acc[ai][0][m][0], b = acc[ai][0][m][1];
                    float s = (a[0] * a[0] + a[1] * a[1]) + (a[2] * a[2] + a[3] * a[3]) + (b[0] * b[0] + b[1] * b[1]) + (b[2] * b[2] + b[3] * b[3]);
                    *(u32x4*)(CKV + (size_t)t * 128 + cb) = pack8(a, b);
                    s += __shfl_xor(s, 16); s += __shfl_xor(s, 32);
                    if (fq == 0) SSKV[(size_t)t * 4 + wc] = s;
                    if (wc == 0) { const f32x4 t1 = acc[ai][1][m][0], t2 = acc[ai][1][m][1];
                        const f32x4 c = *(const f32x4*)(COS + (size_t)t * 16 + 4 * fq), sn = *(const f32x4*)(SIN + (size_t)t * 16 + 4 * fq);
                        const f32x4 o1 = t1 * c - t2 * sn, o2 = t1 * sn + t2 * c;
                        u32x2 w1, w2; w1.x = cvt_pk_bf16(o1[0], o1[1]); w1.y = cvt_pk_bf16(o1[2], o1[3]); w2.x = cvt_pk_bf16(o2[0], o2[1]); w2.y = cvt_pk_bf16(o2[2], o2[3]);
                        *(u32x2*)(KR + (size_t)t * 32 + 4 * fq) = w1; *(u32x2*)(KR + (size_t)t * 32 + 16 + 4 * fq) = w2; }
                    asm volatile("" ::: "memory"); }
        }
    }
};
struct EpiUq {
    static constexpr bool PERM = true, AFTER_DRAIN = false;
    bf16_t* Qm; const float* SSQ; const float* COS; const float* SIN;
    __device__ __forceinline__ void operator()(const f32x4 (&acc)[2][2][4][2], const pg8::Unit& u, int wr, int wc, int fr, int fq) const {
        const int pn = u.pn; const int rowb = u.pm * 256 + wr * 64 + fr;
        const float C2 = 0.10206207261596577f * LOG2E;
#pragma unroll
        for (int ai = 0; ai < 2; ++ai)
#pragma unroll
            for (int m = 0; m < 4; ++m) { const int t = rowb + ai * 128 + m * 16;
                const f32x4 ss = *(const f32x4*)(SSQ + (size_t)t * 4);
                const float f = __builtin_amdgcn_rsqf(((ss[0] + ss[1]) + (ss[2] + ss[3])) * (1.f / 256.f) + EPS) * C2;
                if (pn < 4) {
#pragma unroll
                    for (int bj = 0; bj < 2; ++bj) { const int gc = pn * 256 + bj * 128 + wc * 32 + 8 * fq;
                        *(u32x4*)(Qm + (size_t)t * 1536 + (gc >> 6) * 96 + (gc & 63)) = pack8(acc[ai][bj][m][0] * f, acc[ai][bj][m][1] * f); }
                } else {
                    const f32x4 c = *(const f32x4*)(COS + (size_t)t * 16 + 4 * fq), sn = *(const f32x4*)(SIN + (size_t)t * 16 + 4 * fq);
#pragma unroll
                    for (int bj = 0; bj < 2; ++bj) { const int head = (pn - 4) * 8 + bj * 4 + wc;
                        const f32x4 t1 = acc[ai][bj][m][0] * f, t2 = acc[ai][bj][m][1] * f;
                        const f32x4 o1 = t1 * c - t2 * sn, o2 = t1 * sn + t2 * c;
                        u32x2 w1, w2; w1.x = cvt_pk_bf16(o1[0], o1[1]); w1.y = cvt_pk_bf16(o1[2], o1[3]); w2.x = cvt_pk_bf16(o2[0], o2[1]); w2.y = cvt_pk_bf16(o2[2], o2[3]);
                        bf16_t* p = Qm + (size_t)t * 1536 + head * 96 + 64 + 4 * fq;
                        *(u32x2*)p = w1; *(u32x2*)(p + 16) = w2; }
                }
                asm volatile("" ::: "memory"); }
    }
};
struct EpiUkv {
    static constexpr bool PERM = true, AFTER_DRAIN = false;
    bf16_t* Km; bf16_t* Vm; const float* SSKV;
    __device__ __forceinline__ void operator()(const f32x4 (&acc)[2][2][4][2], const pg8::Unit& u, int wr, int wc, int fr, int fq) const {
        const int pn = u.pn; const int rowb = u.pm * 256 + wr * 64 + fr; const int cb = wc * 32 + 8 * fq;
        bf16_t* base = (pn < 4 ? Km + pn * 256 : Vm + (pn - 4) * 256) + cb;
#pragma unroll
        for (int ai = 0; ai < 2; ++ai)
#pragma unroll
            for (int m = 0; m < 4; ++m) { const int t = rowb + ai * 128 + m * 16;
                const f32x4 ss = *(const f32x4*)(SSKV + (size_t)t * 4);
                const float f = __builtin_amdgcn_rsqf(((ss[0] + ss[1]) + (ss[2] + ss[3])) * (1.f / 128.f) + EPS);
#pragma unroll
                for (int bj = 0; bj < 2; ++bj) *(u32x4*)(base + (size_t)t * 1024 + bj * 128) = pack8(acc[ai][bj][m][0] * f, acc[ai][bj][m][1] * f);
                asm volatile("" ::: "memory"); }
    }
};
struct EpiRes {
    static constexpr bool PERM = false, AFTER_DRAIN = false;
    const float* xin; float* out; const float* gate;
    __device__ __forceinline__ void operator()(const f32x4 (&acc)[2][2][4][2], const pg8::Unit& u, int wr, int wc, int fr, int fq) const {
        const int rowb = u.pm * 256 + wr * 64 + fr; const int c0 = u.pn * 256 + wc * 32 + 4 * fq;
        f32x4 gv[2][2];
#pragma unroll
        for (int bj = 0; bj < 2; ++bj)
#pragma unroll
            for (int n = 0; n < 2; ++n) gv[bj][n] = *(const f32x4*)(gate + c0 + bj * 128 + n * 16);
#pragma unroll
        for (int ai = 0; ai < 2; ++ai)
#pragma unroll
            for (int m = 0; m < 4; ++m) { const int t = rowb + ai * 128 + m * 16;
#pragma unroll
                for (int bj = 0; bj < 2; ++bj)
#pragma unroll
                    for (int n = 0; n < 2; ++n) { const size_t off = (size_t)t * 1024 + c0 + bj * 128 + n * 16;
                        const f32x4 xv = *(const f32x4*)(xin + off); *(f32x4*)(out + off) = xv + gv[bj][n] * acc[ai][bj][m][n]; }
                asm volatile("" ::: "memory"); }
    }
};


#define GEMM_PHASE(EPI, lds, g, S, E) pg8::gemm_phase<EPI, pg8::StaticOrder, true, true>(lds, g, S, E)


constexpr int P4_PITCH = 144, P4_OPB = 128 * P4_PITCH, P4_BUF = 2 * P4_OPB;
__device__ __forceinline__ void p4_pass(const bf16_t* __restrict__ A, int K, const bf16_t* __restrict__ B, int rt, int ct, f32x16& c0, f32x16& c1, LAS char* lds, int tid, int r32, int hi, int wa, int wb) {
    const bf16_t* asrc = A + (size_t)(rt * 128 + (tid >> 2)) * K + (tid & 3) * 8;
    const bf16_t* bsrc = B + (size_t)(ct * 128 + (tid >> 2)) * K + (tid & 3) * 8;
    const int sdst = (tid >> 2) * P4_PITCH + (tid & 3) * 16;
    const int xoff = (wa * 32 + r32) * P4_PITCH + hi * 16, woff = P4_OPB + (wb * 64 + r32) * P4_PITCH + hi * 16;
    const int nk = K >> 6;
    u32x4 ga0 = *(const u32x4*)asrc, ha0 = *(const u32x4*)(asrc + 32), gb0 = *(const u32x4*)bsrc, hb0 = *(const u32x4*)(bsrc + 32), ga1, ha1, gb1, hb1;
    *(LAS u32x4*)(lds + sdst) = ga0; *(LAS u32x4*)(lds + sdst + 64) = ha0; *(LAS u32x4*)(lds + P4_OPB + sdst) = gb0; *(LAS u32x4*)(lds + P4_OPB + sdst + 64) = hb0;
    ga1 = *(const u32x4*)(asrc + 64); ha1 = *(const u32x4*)(asrc + 96); gb1 = *(const u32x4*)(bsrc + 64); hb1 = *(const u32x4*)(bsrc + 96);
    __syncthreads();
    c0 = (f32x16){}; c1 = (f32x16){};
#define P4_STEP(kt, GA_LD, HA_LD, GB_LD, HB_LD, GA_ST, HA_ST, GB_ST, HB_ST) do { \
        const LAS char* buf = lds + ((kt) & 1) * P4_BUF; \
        if ((kt) + 2 < nk) { GA_LD = *(const u32x4*)(asrc + ((kt) + 2) * 64); HA_LD = *(const u32x4*)(asrc + ((kt) + 2) * 64 + 32); GB_LD = *(const u32x4*)(bsrc + ((kt) + 2) * 64); HB_LD = *(const u32x4*)(bsrc + ((kt) + 2) * 64 + 32); } \
        _Pragma("unroll") for (int s = 0; s < 4; ++s) { \
            const bf16x8 x = *(const LAS bf16x8*)(buf + xoff + s * 32); \
            const bf16x8 w0 = *(const LAS bf16x8*)(buf + woff + s * 32), w1 = *(const LAS bf16x8*)(buf + woff + 32 * P4_PITCH + s * 32); \
            c0 = __builtin_amdgcn_mfma_f32_32x32x16_bf16(w0, x, c0, 0, 0, 0); c1 = __builtin_amdgcn_mfma_f32_32x32x16_bf16(w1, x, c1, 0, 0, 0); } \
        if ((kt) + 1 < nk) { LAS char* nb = lds + (((kt) + 1) & 1) * P4_BUF; *(LAS u32x4*)(nb + sdst) = GA_ST; *(LAS u32x4*)(nb + sdst + 64) = HA_ST; *(LAS u32x4*)(nb + P4_OPB + sdst) = GB_ST; *(LAS u32x4*)(nb + P4_OPB + sdst + 64) = HB_ST; } \
        __syncthreads(); } while (0)
    for (int kt = 0; kt < nk; kt += 2) {
        P4_STEP(kt, ga0, ha0, gb0, hb0, ga1, ha1, gb1, hb1);
        P4_STEP(kt + 1, ga1, ha1, gb1, hb1, ga0, ha0, gb0, hb0);
    }
#undef P4_STEP
}
constexpr int P4_BUF2 = 3 * P4_OPB;
__device__ __forceinline__ void p4_pass2(const bf16_t* __restrict__ A, int K, const bf16_t* __restrict__ B0, const bf16_t* __restrict__ B1, int rt, int ct, f32x16& a0, f32x16& a1, f32x16& m0, f32x16& m1, LAS char* lds, int tid, int r32, int hi, int wa, int wb) {
    const bf16_t* asrc = A + (size_t)(rt * 128 + (tid >> 2)) * K + (tid & 3) * 8;
    const bf16_t* bsrc = B0 + (size_t)(ct * 128 + (tid >> 2)) * K + (tid & 3) * 8;
    const bf16_t* csrc = B1 + (size_t)(ct * 128 + (tid >> 2)) * K + (tid & 3) * 8;
    const int sdst = (tid >> 2) * P4_PITCH + (tid & 3) * 16;
    const int xoff = (wa * 32 + r32) * P4_PITCH + hi * 16, woff = P4_OPB + (wb * 64 + r32) * P4_PITCH + hi * 16;
    const int nk = K >> 6;
    u32x4 rA[6], rB[6];
#define P4_LD2(kt, R) do { R[0] = *(const u32x4*)(asrc + (kt) * 64); R[1] = *(const u32x4*)(asrc + (kt) * 64 + 32); R[2] = *(const u32x4*)(bsrc + (kt) * 64); R[3] = *(const u32x4*)(bsrc + (kt) * 64 + 32); \
        R[4] = *(const u32x4*)(csrc + (kt) * 64); R[5] = *(const u32x4*)(csrc + (kt) * 64 + 32); } while (0)
#define P4_ST2(boff, R) do { LAS char* nb_ = lds + (boff); *(LAS u32x4*)(nb_ + sdst) = R[0]; *(LAS u32x4*)(nb_ + sdst + 64) = R[1]; *(LAS u32x4*)(nb_ + P4_OPB + sdst) = R[2]; *(LAS u32x4*)(nb_ + P4_OPB + sdst + 64) = R[3]; \
        *(LAS u32x4*)(nb_ + 2 * P4_OPB + sdst) = R[4]; *(LAS u32x4*)(nb_ + 2 * P4_OPB + sdst + 64) = R[5]; } while (0)
    P4_LD2(0, rA); P4_ST2(0, rA); P4_LD2(1, rB);
    __syncthreads();
    a0 = (f32x16){}; a1 = (f32x16){}; m0 = (f32x16){}; m1 = (f32x16){};
#define P4_STEP2(kt, RL, RS) do { \
        const LAS char* buf = lds + ((kt) & 1) * P4_BUF2; \
        if ((kt) + 2 < nk) P4_LD2((kt) + 2, RL); \
        _Pragma("unroll") for (int s = 0; s < 4; ++s) { \
            const bf16x8 x = *(const LAS bf16x8*)(buf + xoff + s * 32); \
            const bf16x8 w0 = *(const LAS bf16x8*)(buf + woff + s * 32), w1 = *(const LAS bf16x8*)(buf + woff + 32 * P4_PITCH + s * 32); \
            const bf16x8 u0 = *(const LAS bf16x8*)(buf + P4_OPB + woff + s * 32), u1 = *(const LAS bf16x8*)(buf + P4_OPB + woff + 32 * P4_PITCH + s * 32); \
            a0 = __builtin_amdgcn_mfma_f32_32x32x16_bf16(w0, x, a0, 0, 0, 0); a1 = __builtin_amdgcn_mfma_f32_32x32x16_bf16(w1, x, a1, 0, 0, 0); \
            m0 = __builtin_amdgcn_mfma_f32_32x32x16_bf16(u0, x, m0, 0, 0, 0); m1 = __builtin_amdgcn_mfma_f32_32x32x16_bf16(u1, x, m1, 0, 0, 0); } \
        if ((kt) + 1 < nk) P4_ST2((((kt) + 1) & 1) * P4_BUF2, RS); \
        __syncthreads(); } while (0)
    for (int kt = 0; kt < nk; kt += 2) { P4_STEP2(kt, rA, rB); P4_STEP2(kt + 1, rB, rA); }
#undef P4_STEP2
#undef P4_LD2
#undef P4_ST2
}
__device__ __forceinline__ void p4_unit(int rt, int ct, const bf16_t* H, const bf16_t* YA, const bf16_t* YM, const bf16_t* Wga, const bf16_t* Wgm, const bf16_t* Wa, const bf16_t* Wb, bf16_t* MERGED, LAS char* lds) {
    int tid_ = threadIdx.x; asm volatile("" : "+v"(tid_)); const int tid = tid_, lane = tid & 63, r32 = lane & 31, hi = lane >> 5; const int wid = __builtin_amdgcn_readfirstlane(tid >> 6);
    const int wa = wid & 3, wb = wid >> 2;
    f32x16 g0, g1, m0, m1, c0, c1;
    p4_pass2(H, 1024, Wga, Wgm, rt, ct, g0, g1, m0, m1, lds, tid, r32, hi, wa, wb);
#pragma unroll
    for (int r = 0; r < 16; ++r) { g0[r] = sigm_f(g0[r]); g1[r] = sigm_f(g1[r]); m0[r] = sigm_f(m0[r]); m1[r] = sigm_f(m1[r]); }
    p4_pass(YA, 512, Wa, rt, ct, c0, c1, lds, tid, r32, hi, wa, wb);
    g0 *= c0; g1 *= c1;
    p4_pass(YM, 1024, Wb, rt, ct, c0, c1, lds, tid, r32, hi, wa, wb);
    g0 += m0 * c0; g1 += m1 * c1;
    bf16_t* op = MERGED + (size_t)(rt * 128 + wa * 32 + r32) * 1024 + ct * 128 + wb * 64 + 4 * hi;
#pragma unroll
    for (int g4 = 0; g4 < 4; ++g4) { u32x2 w; w.x = cvt_pk_bf16(g0[4 * g4], g0[4 * g4 + 1]); w.y = cvt_pk_bf16(g0[4 * g4 + 2], g0[4 * g4 + 3]); *(u32x2*)(op + 8 * g4) = w;
        u32x2 v; v.x = cvt_pk_bf16(g1[4 * g4], g1[4 * g4 + 1]); v.y = cvt_pk_bf16(g1[4 * g4 + 2], g1[4 * g4 + 3]); *(u32x2*)(op + 32 + 8 * g4) = v; }
}

__device__ __forceinline__ int crow(int r, int hi) { return (r & 3) + 8 * (r >> 2) + 4 * hi; }
__device__ __forceinline__ s16x4 vtr(const LAS char* p) { typedef short v4i16_t __attribute__((ext_vector_type(4))); return __builtin_bit_cast(s16x4, __builtin_amdgcn_ds_read_tr16_b64_v4i16((LAS v4i16_t*)p)); }
__device__ __forceinline__ bf16x8 cat8(s16x4 a, s16x4 b) { return (bf16x8){a[0], a[1], a[2], a[3], b[0], b[1], b[2], b[3]}; }
__device__ __forceinline__ bf16x8 packp(const f32x16& p, int b) { u32x4 w; w.x = cvt_pk_bf16(p[b], p[b + 1]); w.y = cvt_pk_bf16(p[b + 2], p[b + 3]); w.z = cvt_pk_bf16(p[b + 4], p[b + 5]); w.w = cvt_pk_bf16(p[b + 6], p[b + 7]); return __builtin_bit_cast(bf16x8, w); }
__device__ __forceinline__ float max3f(float a, float b, float c) { return fmaxf(fmaxf(a, b), c); }
__device__ __forceinline__ float max16(const f32x16& p) { float a = fmaxf(fmaxf(p[0], p[1]), fmaxf(p[2], p[3])), b = fmaxf(fmaxf(p[4], p[5]), fmaxf(p[6], p[7])), c = fmaxf(fmaxf(p[8], p[9]), fmaxf(p[10], p[11])), d = fmaxf(fmaxf(p[12], p[13]), fmaxf(p[14], p[15])); return fmaxf(fmaxf(a, b), fmaxf(c, d)); }

constexpr int KP = 208, VP = 192, KBUF = 64 * KP, VBUF = 64 * VP, STG = KBUF + VBUF;
__device__ __forceinline__ void mla_unit(int h, int qb, const bf16_t* __restrict__ Qm, const bf16_t* __restrict__ Km, const bf16_t* __restrict__ Kr, const bf16_t* __restrict__ Vm, bf16_t* ZM, LAS char* lds) {
    int tid_ = threadIdx.x; asm volatile("" : "+v"(tid_)); const int tid = tid_, lane = tid & 63, r32 = lane & 31, hi = lane >> 5; const int wid = __builtin_amdgcn_readfirstlane(tid >> 6);
    const int q0 = qb * 256, qrow = q0 + wid * 32 + r32;
    bf16x8 qf[6];
#pragma unroll
    for (int s = 0; s < 6; ++s) qf[s] = *(const bf16x8*)(Qm + (size_t)qrow * 1536 + h * 96 + 16 * s + 8 * hi);
    const int NT = (q0 + 256) / 64;
    const int srow = tid >> 3, sch = tid & 7, rrow = (tid & 255) >> 2, rch = tid & 3;
    const bf16_t* kn_src = Km + (size_t)srow * 1024 + h * 64 + sch * 8;
    const bf16_t* v_src = Vm + (size_t)srow * 1024 + h * 64 + sch * 8;
    const bf16_t* kr_src = Kr + (size_t)rrow * 32 + rch * 8;
    const int kn_dst = srow * KP + sch * 16, kr_dst = rrow * KP + 128 + rch * 16, v_dst = KBUF + srow * VP + sch * 16;
    u32x4 gknA, gkrA, gvA, gknB, gkrB, gvB;
    gknA = *(const u32x4*)kn_src; gvA = *(const u32x4*)v_src; gkrA = *(const u32x4*)kr_src;
    *(LAS u32x4*)(lds + kn_dst) = gknA; *(LAS u32x4*)(lds + v_dst) = gvA; if (tid < 256) *(LAS u32x4*)(lds + kr_dst) = gkrA;
    gknB = *(const u32x4*)(kn_src + (size_t)64 * 1024); gvB = *(const u32x4*)(v_src + (size_t)64 * 1024); gkrB = *(const u32x4*)(kr_src + (size_t)64 * 32);
    __syncthreads();
    float l = 0.f; f32x16 o0 = {}, o1 = {};
    const int ka_off = r32 * KP + hi * 16;
    const int i16 = lane & 15, dg = (lane >> 4) & 1;
    const int va_off = KBUF + (4 * hi + (i16 >> 2)) * VP + (16 * dg + 4 * (i16 & 3)) * 2;
    float mref = 0.f; f32x16 negm = {};
#define MLA_SB() __builtin_amdgcn_sched_barrier(0)
#define MLA_EX4(S, b) do { S[b] = fast_exp2(S[b]); S[b + 1] = fast_exp2(S[b + 1]); S[b + 2] = fast_exp2(S[b + 2]); S[b + 3] = fast_exp2(S[b + 3]); ps += (S[b] + S[b + 1]) + (S[b + 2] + S[b + 3]); } while (0)
#define MLA_STEP(t, GKN_LD, GV_LD, GKR_LD, GKN_ST, GV_ST, GKR_ST) do { \
        const LAS char* buf = lds + ((t) & 1) * STG; \
        { const size_t o = (size_t)((t) + 2 < NT ? (t) + 2 : NT - 1) * 64; GKN_LD = *(const u32x4*)(kn_src + o * 1024); GV_LD = *(const u32x4*)(v_src + o * 1024); GKR_LD = *(const u32x4*)(kr_src + o * 32); }     \
        const int jb = (t) - (NT - 4); \
        if (!(jb >= 0 && 2 * jb > wid)) { \
              \
            bf16x8 ka[6], kb[6]; \
            _Pragma("unroll") for (int s = 0; s < 6; ++s) ka[s] = *(const LAS bf16x8*)(buf + ka_off + s * 32); \
            MLA_SB(); \
            _Pragma("unroll") for (int s = 0; s < 6; ++s) kb[s] = *(const LAS bf16x8*)(buf + ka_off + 32 * KP + s * 32); \
            MLA_SB(); \
            f32x16 s0 = negm, s1 = negm; float ps = 0.f; \
            __builtin_amdgcn_s_setprio(1); \
              \
            s0 = __builtin_amdgcn_mfma_f32_32x32x16_bf16(ka[0], qf[0], s0, 0, 0, 0); s1 = __builtin_amdgcn_mfma_f32_32x32x16_bf16(kb[0], qf[0], s1, 0, 0, 0); \
            s0 = __builtin_amdgcn_mfma_f32_32x32x16_bf16(ka[1], qf[1], s0, 0, 0, 0); s1 = __builtin_amdgcn_mfma_f32_32x32x16_bf16(kb[1], qf[1], s1, 0, 0, 0); \
            MLA_SB(); \
            const LAS char* vp0 = buf + va_off; \
            s16x4 v0[8]; \
            _Pragma("unroll") for (int ks = 0; ks < 2; ++ks) { v0[4 * ks] = vtr(vp0 + ks * 16 * VP); v0[4 * ks + 1] = vtr(vp0 + ks * 16 * VP + 8 * VP); v0[4 * ks + 2] = vtr(vp0 + ks * 16 * VP + 64); v0[4 * ks + 3] = vtr(vp0 + ks * 16 * VP + 8 * VP + 64); } \
            _Pragma("unroll") for (int s = 2; s < 6; ++s) s0 = __builtin_amdgcn_mfma_f32_32x32x16_bf16(ka[s], qf[s], s0, 0, 0, 0); \
            MLA_SB(); \
            if (jb >= 0) { _Pragma("unroll") for (int r = 0; r < 16; ++r) { const int kv = 64 * (t) + crow(r, hi); if (kv > qrow) s0[r] = NEGB; } } \
            float ra = max3f(s0[0], s0[1], s0[2]); ra = max3f(ra, s0[3], s0[4]); ra = max3f(ra, s0[5], s0[6]); ra = max3f(ra, s0[7], s0[8]); ra = max3f(ra, s0[9], s0[10]); ra = max3f(ra, s0[11], s0[12]); ra = max3f(ra, s0[13], s0[14]); ra = fmaxf(ra, s0[15]); \
            s1 = __builtin_amdgcn_mfma_f32_32x32x16_bf16(kb[2], qf[2], s1, 0, 0, 0); MLA_EX4(s0, 0); MLA_SB(); \
            s1 = __builtin_amdgcn_mfma_f32_32x32x16_bf16(kb[3], qf[3], s1, 0, 0, 0); MLA_EX4(s0, 4); MLA_SB(); \
            bf16x8 pb0, pb1; \
            s1 = __builtin_amdgcn_mfma_f32_32x32x16_bf16(kb[4], qf[4], s1, 0, 0, 0); MLA_EX4(s0, 8); pb0 = packp(s0, 0); MLA_SB(); \
            s1 = __builtin_amdgcn_mfma_f32_32x32x16_bf16(kb[5], qf[5], s1, 0, 0, 0); MLA_EX4(s0, 12); MLA_SB(); \
            pb1 = packp(s0, 8); \
            __builtin_amdgcn_s_setprio(0); \
            s16x4 v1[8];                                                       \
            _Pragma("unroll") for (int ks = 0; ks < 2; ++ks) { v1[4 * ks] = vtr(vp0 + (ks + 2) * 16 * VP); v1[4 * ks + 1] = vtr(vp0 + (ks + 2) * 16 * VP + 8 * VP); v1[4 * ks + 2] = vtr(vp0 + (ks + 2) * 16 * VP + 64); v1[4 * ks + 3] = vtr(vp0 + (ks + 2) * 16 * VP + 8 * VP + 64); } \
            MLA_SB(); \
            if (jb >= 0) { _Pragma("unroll") for (int r = 0; r < 16; ++r) { const int kv = 64 * (t) + crow(r, hi); if (kv + 32 > qrow) s1[r] = NEGB; } } \
            float rb = max3f(s1[0], s1[1], s1[2]); rb = max3f(rb, s1[3], s1[4]); rb = max3f(rb, s1[5], s1[6]); rb = max3f(rb, s1[7], s1[8]); rb = max3f(rb, s1[9], s1[10]); rb = max3f(rb, s1[11], s1[12]); rb = max3f(rb, s1[13], s1[14]); rb = fmaxf(rb, s1[15]); \
            float rm = fmaxf(ra, rb); { const auto rr_ = __builtin_amdgcn_permlane32_swap(__float_as_uint(rm), __float_as_uint(rm), false, false); rm = fmaxf(__uint_as_float(rr_[0]), __uint_as_float(rr_[1])); }     \
            if ((t) == 0 || __any(rm > 8.0f)) { \
                const float dl = (t) == 0 ? rm : fmaxf(rm, 0.f); mref += dl; const float f = fast_exp2(-dl); \
                _Pragma("unroll") for (int r = 0; r < 16; ++r) { s0[r] *= f; s1[r] -= dl; negm[r] = -mref; } \
                ps *= f; l *= f; o0 *= f; o1 *= f; pb0 = packp(s0, 0); pb1 = packp(s0, 8); } \
            MLA_SB(); \
            __builtin_amdgcn_s_setprio(1); \
            o0 = __builtin_amdgcn_mfma_f32_32x32x16_bf16(cat8(v0[0], v0[1]), pb0, o0, 0, 0, 0); MLA_EX4(s1, 0); MLA_SB(); \
            o1 = __builtin_amdgcn_mfma_f32_32x32x16_bf16(cat8(v0[2], v0[3]), pb0, o1, 0, 0, 0); MLA_EX4(s1, 4); MLA_SB(); \
            bf16x8 pb2; \
            o0 = __builtin_amdgcn_mfma_f32_32x32x16_bf16(cat8(v0[4], v0[5]), pb1, o0, 0, 0, 0); MLA_EX4(s1, 8); pb2 = packp(s1, 0); MLA_SB(); \
            o1 = __builtin_amdgcn_mfma_f32_32x32x16_bf16(cat8(v0[6], v0[7]), pb1, o1, 0, 0, 0); MLA_EX4(s1, 12); MLA_SB(); \
            l += ps; \
            const bf16x8 pb3 = packp(s1, 8); \
            MLA_SB(); \
            o0 = __builtin_amdgcn_mfma_f32_32x32x16_bf16(cat8(v1[0], v1[1]), pb2, o0, 0, 0, 0); o1 = __builtin_amdgcn_mfma_f32_32x32x16_bf16(cat8(v1[2], v1[3]), pb2, o1, 0, 0, 0); \
            o0 = __builtin_amdgcn_mfma_f32_32x32x16_bf16(cat8(v1[4], v1[5]), pb3, o0, 0, 0, 0); o1 = __builtin_amdgcn_mfma_f32_32x32x16_bf16(cat8(v1[6], v1[7]), pb3, o1, 0, 0, 0); \
            __builtin_amdgcn_s_setprio(0); \
            MLA_SB(); \
        } \
        if ((t) + 1 < NT) { LAS char* nb = lds + (((t) + 1) & 1) * STG; *(LAS u32x4*)(nb + kn_dst) = GKN_ST; *(LAS u32x4*)(nb + v_dst) = GV_ST; if (tid < 256) *(LAS u32x4*)(nb + kr_dst) = GKR_ST; } \
        __syncthreads(); } while (0)
    for (int t = 0; t < NT; t += 2) {
        MLA_STEP(t, gknA, gvA, gkrA, gknB, gvB, gkrB);
        MLA_STEP(t + 1, gknB, gvB, gkrB, gknA, gvA, gkrA);
    }
#undef MLA_STEP
#undef MLA_EX4
#undef MLA_SB
    l += __shfl_xor(l, 32); const float rl = fast_rcp(l);
    bf16_t* zp = ZM + (size_t)qrow * 1024 + h * 64 + 4 * hi;
#pragma unroll
    for (int db = 0; db < 2; ++db)
#pragma unroll
        for (int g4 = 0; g4 < 4; ++g4) { bf16_t* p = zp + 32 * db + 8 * g4; const u32x2 z = *(const u32x2*)p; const f32x16& o = db ? o1 : o0;
            u32x2 w; w.x = cvt_pk_bf16(o[4 * g4] * rl * bflo(z.x), o[4 * g4 + 1] * rl * bfhi(z.x)); w.y = cvt_pk_bf16(o[4 * g4 + 2] * rl * bflo(z.y), o[4 * g4 + 3] * rl * bfhi(z.y));
            *(u32x2*)p = w; }
}

constexpr int DL_V = 0, DL_LSE = 8 * 32 * VP, DL_TAB = DL_LSE + 3 * 512 * 4;
__device__ __forceinline__ void dil_unit(int hs, int un, bf16_t* BIG, bf16_t* ZA, const float* __restrict__ BT, LAS char* lds) {
    int tid_ = threadIdx.x; asm volatile("" : "+v"(tid_)); const int tid = tid_, lane = tid & 63, r32 = lane & 31, hi = lane >> 5; const int wid = __builtin_amdgcn_readfirstlane(tid >> 6);
    const int T0 = un * 512;
    LAS float* lse_l = (LAS float*)(lds + DL_LSE); LAS float* tab = (LAS float*)(lds + DL_TAB);
    for (int i = tid; i < 576; i += 512) tab[i] = BT[((i / 192) * 8 + hs) * 192 + (i % 192)];
    __syncthreads();
    LAS char* vst = lds + DL_V + wid * 32 * VP;
    const int i16 = lane & 15, dg = (lane >> 4) & 1;
    const int va_off = (4 * hi + (i16 >> 2)) * VP + (16 * dg + 4 * (i16 & 3)) * 2;
    for (int k = 0; k < 6; ++k) {
        const int item = wid + 8 * k, g = item >> 4, b = item & 15, sh = 2 * g, L = SEQ >> sh;
        const int p = b >> (4 - sh), sub = b & ((16 >> sh) - 1), m0 = (T0 >> sh) + 32 * sub;
        const size_t rowbase = (size_t)p * L;
        bf16_t* Qg = BIG + (size_t)(0 * 3 + g) * GSZ; const bf16_t* Kg = BIG + (size_t)(1 * 3 + g) * GSZ; const bf16_t* Vg = BIG + (size_t)(2 * 3 + g) * GSZ;
        const size_t qrow = rowbase + m0 + r32;
        bf16x8 qf[4];
#pragma unroll
        for (int s = 0; s < 4; ++s) qf[s] = *(const bf16x8*)(Qg + qrow * 512 + hs * 64 + 16 * s + 8 * hi);
        float mrun = NEGB, l = 0.f; f32x16 o0 = {}, o1 = {};
        const LAS float* tg = tab + g * 192;
        for (int c = 0; c < 5; ++c) {
            const int ks0 = m0 - 128 + 32 * c; if (ks0 < 0) continue;
            const bf16_t* kp = Kg + (rowbase + ks0 + r32) * 512 + hs * 64 + 8 * hi;
            bf16x8 ka[4];
#pragma unroll
            for (int s = 0; s < 4; ++s) ka[s] = *(const bf16x8*)(kp + 16 * s);
            u32x4 vv[4];
#pragma unroll
            for (int i = 0; i < 4; ++i) vv[i] = *(const u32x4*)(Vg + (rowbase + ks0 + (lane >> 3) + 8 * i) * 512 + hs * 64 + (lane & 7) * 8);
            f32x16 sc = {};
#pragma unroll
            for (int s = 0; s < 4; ++s) sc = __builtin_amdgcn_mfma_f32_32x32x16_bf16(ka[s], qf[s], sc, 0, 0, 0);
#pragma unroll
            for (int r = 0; r < 16; ++r) sc[r] += tg[160 - 32 * c + r32 - crow(r, hi)];
            float rm = max16(sc); rm = fmaxf(rm, __shfl_xor(rm, 32));
            const float mn = fmaxf(mrun, rm), alpha = fast_exp2(mrun - mn); mrun = mn;
            float ps = 0.f;
#pragma unroll
            for (int r = 0; r < 16; ++r) { sc[r] = fast_exp2(sc[r] - mn); ps += sc[r]; }
            l = l * alpha + ps; o0 *= alpha; o1 *= alpha;
            const bf16x8 pb0 = packp(sc, 0), pb1 = packp(sc, 8);
#pragma unroll
            for (int i = 0; i < 4; ++i) *(LAS u32x4*)(vst + ((lane >> 3) + 8 * i) * VP + (lane & 7) * 16) = vv[i];
            asm volatile("s_waitcnt lgkmcnt(0)" ::: "memory");
#pragma unroll
            for (int ks = 0; ks < 2; ++ks) { const bf16x8 pb = ks == 0 ? pb0 : pb1;
                const LAS char* vp = vst + va_off + ks * 16 * VP;
                const bf16x8 a0 = cat8(vtr(vp), vtr(vp + 8 * VP)), a1 = cat8(vtr(vp + 64), vtr(vp + 8 * VP + 64));
                o0 = __builtin_amdgcn_mfma_f32_32x32x16_bf16(a0, pb, o0, 0, 0, 0); o1 = __builtin_amdgcn_mfma_f32_32x32x16_bf16(a1, pb, o1, 0, 0, 0); }
            asm volatile("s_waitcnt lgkmcnt(0)" ::: "memory");
        }
        l += __shfl_xor(l, 32); const float rl = fast_rcp(l);
        if (hi == 0) lse_l[g * 512 + ((m0 + r32) << sh) + p - T0] = mrun + __builtin_amdgcn_logf(l);
        bf16_t* op = Qg + qrow * 512 + hs * 64 + 4 * hi;
#pragma unroll
        for (int db = 0; db < 2; ++db)
#pragma unroll
            for (int g4 = 0; g4 < 4; ++g4) { const f32x16& o = db ? o1 : o0;
                u32x2 w; w.x = cvt_pk_bf16(o[4 * g4] * rl, o[4 * g4 + 1] * rl); w.y = cvt_pk_bf16(o[4 * g4 + 2] * rl, o[4 * g4 + 3] * rl);
                *(u32x2*)(op + 32 * db + 8 * g4) = w; }
    }
    __syncthreads();
#pragma unroll 2
    for (int k = 0; k < 8; ++k) {
        const int piece = tid + 512 * k, tl = piece >> 3, ch = piece & 7, t = T0 + tl;
        const float l0 = lse_l[tl], l1 = lse_l[512 + tl], l2 = lse_l[1024 + tl];
        const float mx = fmaxf(l0, fmaxf(l1, l2));
        float w0 = fast_exp2(l0 - mx), w1 = fast_exp2(l1 - mx), w2 = fast_exp2(l2 - mx); const float rs = fast_rcp(w0 + w1 + w2); w0 *= rs; w1 *= rs; w2 *= rs;
        const u32x4 a = *(const u32x4*)(BIG + (size_t)t * 512 + hs * 64 + ch * 8);
        const u32x4 bq = *(const u32x4*)(BIG + GSZ + ((size_t)(t & 3) * (SEQ >> 2) + (t >> 2)) * 512 + hs * 64 + ch * 8);
        const u32x4 cq = *(const u32x4*)(BIG + 2 * GSZ + ((size_t)(t & 15) * (SEQ >> 4) + (t >> 4)) * 512 + hs * 64 + ch * 8);
        bf16_t* zp = ZA + (size_t)t * 512 + hs * 64 + ch * 8; const u32x4 z = *(const u32x4*)zp;
        u32x4 w;
#define CMB(f) w.f = cvt_pk_bf16((w0 * bflo(a.f) + w1 * bflo(bq.f) + w2 * bflo(cq.f)) * bflo(z.f), (w0 * bfhi(a.f) + w1 * bfhi(bq.f) + w2 * bfhi(cq.f)) * bfhi(z.f))
        CMB(x); CMB(y); CMB(z); CMB(w);
#undef CMB
        *(u32x4*)zp = w;
    }
    __syncthreads();
}


#define XB_TMO      128
#define XB_XCNT(j)  (256  + 64 * (j))
#define XB_XSUB(j)  (1280 + 64 * (j))
#define XB_XGEN(j)  (2304 + 64 * (j))
#define XB_TOP      3328
#define XB_TOPGEN   3392
#define XCD_BAR_WORDS 3456
#define XB_SPIN_CAP (1u << 18)

__device__ __forceinline__ unsigned xb_ld(unsigned* p)              { return __hip_atomic_load(p, __ATOMIC_RELAXED, __HIP_MEMORY_SCOPE_AGENT); }
__device__ __forceinline__ unsigned xb_add(unsigned* p, unsigned v) { return __hip_atomic_fetch_add(p, v, __ATOMIC_RELAXED, __HIP_MEMORY_SCOPE_AGENT); }
__device__ __forceinline__ unsigned xb_xcc_id() { return (unsigned)__builtin_amdgcn_s_getreg((3 << 11) | 20) & 0xFu; }
#define XB_SPIN(cond, bar) do { unsigned _sp = 0; while (cond) { __builtin_amdgcn_s_sleep(1); \
    if ((++_sp & 255u) == 0u) { if (xb_ld(&(bar)[XB_TMO])) break; if (_sp > XB_SPIN_CAP) { atomicAdd(&(bar)[XB_TMO], 1u); break; } } } } while (0)

struct XcdBarrier {
    unsigned* bar; unsigned x;
    volatile LAS unsigned* st;
};

__device__ __forceinline__ XcdBarrier xcd_barrier_post(unsigned* bar, volatile LAS unsigned* st) {
    XcdBarrier b; b.bar = bar; b.x = xb_xcc_id(); b.st = st;
    if (threadIdx.x == 0) (void)xb_add(&bar[XB_XCNT(b.x)], 1u);
    return b;
}
__device__ __forceinline__ void xcd_barrier_complete(unsigned* bar, unsigned x, unsigned& nloc, unsigned& nx) {
    const unsigned G = gridDim.x * gridDim.y * gridDim.z;
    unsigned sum, cnt, mine, sp = 0u;
    for (;;) {
        sum = 0u; cnt = 0u; mine = 0u;
#pragma unroll
        for (unsigned j = 0; j < 16; ++j) { const unsigned c = xb_ld(&bar[XB_XCNT(j)]); sum += c; cnt += (c > 0u) ? 1u : 0u; mine = (j == x) ? c : mine; }
        if (sum == G) break;
        __builtin_amdgcn_s_sleep(1);
        if ((++sp & 255u) == 0u) { if (xb_ld(&bar[XB_TMO])) break; if (sp > XB_SPIN_CAP) { atomicAdd(&bar[XB_TMO], 1u); break; } }
    }
    nloc = mine > 0u ? mine : 1u; nx = cnt > 0u ? cnt : 1u;
}

__device__ __forceinline__ void xcd_barrier(const XcdBarrier& b) {
    asm volatile("s_waitcnt vmcnt(0)" ::: "memory");
    __syncthreads();
    if (threadIdx.x == 0) {
        unsigned* bar = b.bar;
        __builtin_amdgcn_s_waitcnt(0);
        unsigned nloc = b.st[0], nx = b.st[1];
        if (nloc == 0u) { xcd_barrier_complete(bar, b.x, nloc, nx); b.st[0] = nloc; b.st[1] = nx; }
        const unsigned old = xb_add(&bar[XB_XSUB(b.x)], 1u);
        const unsigned gen = old / nloc;
        if (old + 1u == (gen + 1u) * nloc) {
            __builtin_amdgcn_fence(__ATOMIC_RELEASE, "agent");
            asm volatile("s_waitcnt vmcnt(0)" ::: "memory");
            const unsigned og = xb_add(&bar[XB_TOP], 1u);
            const unsigned tg = og / nx;
            if (og + 1u == (tg + 1u) * nx) xb_add(&bar[XB_TOPGEN], 1u);
            else XB_SPIN(xb_ld(&bar[XB_TOPGEN]) == tg, bar);
            __builtin_amdgcn_fence(__ATOMIC_ACQUIRE, "agent");
            xb_add(&bar[XB_XGEN(b.x)], 1u);
            asm volatile("s_waitcnt vmcnt(0)" ::: "memory");
        } else {
            XB_SPIN(xb_ld(&bar[XB_XGEN(b.x)]) == gen, bar);
            __builtin_amdgcn_fence(__ATOMIC_ACQUIRE, "agent");
            asm volatile("s_waitcnt vmcnt(0)" ::: "memory");
        }
    }
    __syncthreads();
}

__device__ __forceinline__ float wave_sum(float v) {
#pragma unroll
    for (int o = 1; o < 64; o <<= 1) v += __shfl_xor(v, o);
    return v;
}
__device__ __forceinline__ int rope_pos(int i) { return i < 16 ? 8 * (i >> 2) + (i & 3) : 8 * ((i - 16) >> 2) + 4 + (i & 3); }
__device__ __forceinline__ int dst_row(int mode, int n) {
    if (mode == 1) { if (n < 5504) return n; if (n < 5536) return 5504 + rope_pos(n - 5504); if (n < 6560) return 5632 + (n - 5536); return 6656 + (n - 6560); }
    if (mode == 2) { const int hd = n / 96, e = n - hd * 96; return e < 64 ? hd * 64 + e : 1024 + hd * 32 + rope_pos(e - 64); }
    if (mode == 3) { const int hd = n >> 7, e = n & 127; return e < 64 ? hd * 64 + e : 1024 + hd * 64 + (e - 64); }
    return n;
}
__device__ __forceinline__ void transpose_item(const float* __restrict__ W, int K, int N, bf16_t* WT, int mode, const float* __restrict__ kscale, LAS float* scr, int item, int lane) {
    const int nblk = N / 32, kb = item / nblk, nb = item % nblk, k0 = 64 * kb, n0 = 32 * nb;
#pragma unroll 8
    for (int i = 0; i < 32; ++i) { const int kk = 2 * i + (lane >> 5); float v = W[(size_t)(k0 + kk) * N + n0 + (lane & 31)]; if (kscale) v *= kscale[k0 + kk]; scr[kk * 33 + (lane & 31)] = v; }
    asm volatile("s_waitcnt lgkmcnt(0)" ::: "memory");
    const int c = lane & 7;
#pragma unroll
    for (int j = 0; j < 4; ++j) { const int n = (lane >> 3) + 8 * j; const LAS float* s = scr + (8 * c) * 33 + n;
        u32x4 o; o.x = cvt_pk_bf16(s[0 * 33], s[1 * 33]); o.y = cvt_pk_bf16(s[2 * 33], s[3 * 33]); o.z = cvt_pk_bf16(s[4 * 33], s[5 * 33]); o.w = cvt_pk_bf16(s[6 * 33], s[7 * 33]);
        *(u32x4*)(WT + (size_t)dst_row(mode, n0 + n) * K + k0 + 8 * c) = o; }
    asm volatile("s_waitcnt lgkmcnt(0)" ::: "memory");
}

struct Args { const float* in[16]; float* out; unsigned char* ws; int ph_lo, ph_hi; };
typedef const __attribute__((address_space(4))) Args* KArgs;

__device__ __forceinline__ void convert_weights(KArgs a, int layer, unsigned char* ws, LAS unsigned char* lds, int gw, int NGW, int wave, int lane) {
    LAS float* scr = (LAS float*)(lds + wave * 16384);
    const float* w_in = a->in[6] + (size_t)layer * DM * DIN; const float* w_uq = a->in[8] + (size_t)layer * 256 * 1536; const float* w_ukv = a->in[10] + (size_t)layer * 128 * 2048;
    const float* w_a = a->in[11] + (size_t)layer * 512 * 1024; const float* w_b = a->in[12] + (size_t)layer * 1024 * 1024; const float* w_o = a->in[13] + (size_t)layer * 1024 * 1024;
    const float* qg = a->in[7] + layer * 256; const float* kvg = a->in[9] + layer * 128;
    constexpr int I_IN = 16 * 269, I_UQ = 4 * 48, I_UKV = 2 * 64, I_A = 8 * 32, I_B = 16 * 32, I_O = 16 * 32, NIT = I_IN + I_UQ + I_UKV + I_A + I_B + I_O;
    for (int it = gw; it < NIT; it += NGW) {
        int r = it;
        if (r < I_IN) { transpose_item(w_in, 1024, DIN, (bf16_t*)(ws + WS_WIN), 1, nullptr, scr, r, lane); continue; } r -= I_IN;
        if (r < I_UQ) { transpose_item(w_uq, 256, 1536, (bf16_t*)(ws + WS_WUQ), 2, qg, scr, r, lane); continue; } r -= I_UQ;
        if (r < I_UKV) { transpose_item(w_ukv, 128, 2048, (bf16_t*)(ws + WS_WUKV), 3, kvg, scr, r, lane); continue; } r -= I_UKV;
        if (r < I_A) { transpose_item(w_a, 512, 1024, (bf16_t*)(ws + WS_WA), 0, nullptr, scr, r, lane); continue; } r -= I_A;
        if (r < I_B) { transpose_item(w_b, 1024, 1024, (bf16_t*)(ws + WS_WB), 0, nullptr, scr, r, lane); continue; } r -= I_B;
        transpose_item(w_o, 1024, 1024, (bf16_t*)(ws + WS_WO), 0, nullptr, scr, r, lane);
    }
}
__device__ __forceinline__ void adaln_rows(const float* x, const float* g, const float* mod, bf16_t* H, int gw, int NGW, int lane) {
    for (int m = gw; m < SEQ; m += NGW) {
        const f32x4* xr = (const f32x4*)(x + (size_t)m * DM) + lane; f32x4 v[4]; float s = 0.f;
#pragma unroll
        for (int j = 0; j < 4; ++j) { v[j] = xr[64 * j]; s += (v[j][0] * v[j][0] + v[j][1] * v[j][1]) + (v[j][2] * v[j][2] + v[j][3] * v[j][3]); }
        const float rstd = __builtin_amdgcn_rsqf(wave_sum(s) * (1.f / DM) + EPS);
        u32x2* o8 = (u32x2*)(H + (size_t)m * DM) + lane;
#pragma unroll
        for (int j = 0; j < 4; ++j) { const int c = 256 * j + 4 * lane; const f32x4 gg = *(const f32x4*)(g + c), sh = *(const f32x4*)(mod + c), sc = *(const f32x4*)(mod + 1024 + c);
            const f32x4 y = v[j] * rstd * gg * (sc + 1.f) + sh; u32x2 w; w.x = cvt_pk_bf16(y[0], y[1]); w.y = cvt_pk_bf16(y[2], y[3]); o8[64 * j] = w; }
    }
}
__device__ __forceinline__ void final_rows(float* x, const float* g, int gw, int NGW, int lane) {
    for (int m = gw; m < SEQ; m += NGW) {
        f32x4* xr = (f32x4*)(x + (size_t)m * DM) + lane; f32x4 v[4]; float s = 0.f;
#pragma unroll
        for (int j = 0; j < 4; ++j) { v[j] = xr[64 * j]; s += (v[j][0] * v[j][0] + v[j][1] * v[j][1]) + (v[j][2] * v[j][2] + v[j][3] * v[j][3]); }
        const float rstd = __builtin_amdgcn_rsqf(wave_sum(s) * (1.f / DM) + EPS);
#pragma unroll
        for (int j = 0; j < 4; ++j) { const f32x4 gg = *(const f32x4*)(g + 256 * j + 4 * lane); xr[64 * j] = v[j] * rstd * gg; }
    }
}

#define KARGS(name) KArgs name = (KArgs)__builtin_amdgcn_kernarg_segment_ptr(); asm volatile("" : "+s"(name))
#define GRID_SYNC() do { KARGS(kb_); XcdBarrier b_; b_.bar = (unsigned*)(kb_->ws + WS_BAR); b_.x = xb_xcc_id(); b_.st = (volatile LAS unsigned*)(lds + LDS_ST); xcd_barrier(b_); } while (0)
struct Ids { int G, bx, vcu; };
__device__ __forceinline__ Ids get_ids() { Ids r; r.G = gridDim.x; r.bx = blockIdx.x; r.vcu = (r.G % 8 == 0) ? (r.bx % 8) * (r.G / 8) + r.bx / 8 : r.bx; return r; }
#define FRESH_TID() int tid_ = threadIdx.x; asm volatile("" : "+v"(tid_)); const int tid = tid_, lane = tid & 63; const int wave = __builtin_amdgcn_readfirstlane(tid >> 6); (void)lane; (void)wave

__global__ void __launch_bounds__(NWAVES * 64, 2) fwd_mega(Args a_unused) {
    extern __shared__ __attribute__((aligned(16))) unsigned char lds_raw[];
    LAS unsigned char* lds = (LAS unsigned char*)lds_raw;
    int ph_lo, ph_hi; { KARGS(kp); ph_lo = kp->ph_lo; ph_hi = kp->ph_hi; }
    if (ph_lo < 0) cg::this_grid().sync();
    { KARGS(kb0); if (threadIdx.x < 2) ((LAS unsigned*)(lds + LDS_ST))[threadIdx.x] = 0u; __syncthreads(); (void)xcd_barrier_post((unsigned*)(kb0->ws + WS_BAR), (volatile LAS unsigned*)(lds + LDS_ST)); }
#define IN(k) (ph_lo <= (k) && (k) < ph_hi)
#define SEAM(k) do { if (IN(k) && IN((k) + 1)) GRID_SYNC(); } while (0)

    if (IN(0)) {
        KARGS(ka); FRESH_TID(); const Ids id = get_ids(); const int G = id.G, bx = id.bx;
        unsigned char* ws = ka->ws; const float* cvec = ka->in[1]; const int* pos = (const int*)ka->in[2]; const float* w_ada = ka->in[3]; const float* b_ada = ka->in[4]; const float* rel_bias = ka->in[14];
        float* MOD = (float*)(ws + WS_MOD); float* BT = (float*)(ws + WS_BT); float* COS = (float*)(ws + WS_COS); float* SIN = (float*)(ws + WS_SIN);
        LAS float* red = (LAS float*)(lds + 8 * 16384);
        for (int it = bx; it < 192; it += G) {
            const int l = it / 96, n0 = (it % 96) * 32, col = lane & 31, kh = lane >> 5; const float* wp = w_ada + (size_t)l * DM * 3072 + n0 + col; float s = 0.f;
            const int kbeg = wave * 128 + kh * 64;
#pragma unroll 16
            for (int k = 0; k < 64; ++k) { const float cv = cvec[kbeg + k]; s += silu_f(cv) * wp[(size_t)(kbeg + k) * 3072]; }
            red[wave * 64 + lane] = s; __syncthreads();
            if (tid < 32) { float t = b_ada[l * 3072 + n0 + tid]; for (int i = 0; i < 16; ++i) t += red[i * 32 + tid]; MOD[l * 3072 + n0 + tid] = t; }
            __syncthreads();
        }
        const int gt = id.vcu * 512 + tid, NGT = G * 512;
        for (int i = gt; i < 24 * 192; i += NGT) { const int gh = i / 192, idx = i % 192, g = gh >> 3, j = idx - 32; float v = NEGB;
            if (j >= 0 && j <= 128) { const int dist = j << (2 * g); int bucket;
                if (dist < 16) bucket = dist; else { bucket = 16 + (int)(logf((float)dist / 16.f) / 4.852030263919617f * 16.f); bucket = bucket < 31 ? bucket : 31; }
                v = rel_bias[bucket * 24 + gh] * LOG2E; }
            BT[i] = v; }
        for (int i = gt; i < SEQ * 16; i += NGT) { const int t = i >> 4, f = i & 15; const float inv = 1.0f / exp2f((float)f * (13.287712379549449f / 16.f));
            const float ang = (float)pos[t] * inv; double rev = (double)ang * 0.15915494309189535; rev -= floor(rev);
            COS[i] = __builtin_amdgcn_cosf((float)rev); SIN[i] = __builtin_amdgcn_sinf((float)rev); }
        convert_weights(ka, 0, ws, lds, id.vcu * NWAVES + wave, G * NWAVES, wave, lane);
    }
    SEAM(0);
#pragma unroll
    for (int layer = 0; layer < 2; ++layer) {
        const int pb = 1 + 7 * layer;
        if (IN(pb)) {
            KARGS(ka); FRESH_TID(); const Ids id = get_ids(); unsigned char* ws = ka->ws;
            if (layer == 1) convert_weights(ka, 1, ws, lds, id.vcu * NWAVES + wave, id.G * NWAVES, wave, lane);
            adaln_rows(layer == 0 ? ka->in[0] : (const float*)ka->out, ka->in[5] + layer * DM, (const float*)(ws + WS_MOD) + layer * 3072, (bf16_t*)(ws + WS_H), id.vcu * NWAVES + wave, id.G * NWAVES, lane);
        }
        SEAM(pb + 0);
#if PH&1
        if (IN(pb + 1))
        { KARGS(ka); const Ids id = get_ids(); unsigned char* ws = ka->ws;
          pg8::Gemm g{(const bf16_t*)(ws + WS_H), (const bf16_t*)(ws + WS_WIN), SEQ, 6656, 1024}; pg8::StaticOrder S; S.init(SEQ, 6656, id.G, id.bx);
          EpiIn E{(bf16_t*)(ws + WS_BIG), (bf16_t*)(ws + WS_ZA), (bf16_t*)(ws + WS_ZM), (bf16_t*)(ws + WS_CQ), (bf16_t*)(ws + WS_CKV), (bf16_t*)(ws + WS_KR), (float*)(ws + WS_SSQ), (float*)(ws + WS_SSKV), (const float*)(ws + WS_COS), (const float*)(ws + WS_SIN)};
          GEMM_PHASE(EpiIn, lds, g, S, E); }
#endif
        SEAM(pb + 1);
#if PH&2
        if (IN(pb + 2))
        { KARGS(ka); const Ids id = get_ids(); unsigned char* ws = ka->ws;
          for (int un = id.vcu; un < 256; un += id.G) dil_unit(un >> 5, un & 31, (bf16_t*)(ws + WS_BIG), (bf16_t*)(ws + WS_ZA), (const float*)(ws + WS_BT), (LAS char*)lds);
        }
#endif
        SEAM(pb + 2);
#if PH&4
        if (IN(pb + 3))
        { KARGS(ka); const Ids id = get_ids(); unsigned char* ws = ka->ws; bf16_t* Qm = (bf16_t*)(ws + WS_BIG);
          { pg8::Gemm g{(const bf16_t*)(ws + WS_CQ), (const bf16_t*)(ws + WS_WUQ), SEQ, 1536, 256}; pg8::StaticOrder S; S.init(SEQ, 1536, id.G, id.bx); EpiUq E{Qm, (const float*)(ws + WS_SSQ), (const float*)(ws + WS_COS), (const float*)(ws + WS_SIN)};
            GEMM_PHASE(EpiUq, lds, g, S, E); }
          { pg8::Gemm g{(const bf16_t*)(ws + WS_CKV), (const bf16_t*)(ws + WS_WUKV), SEQ, 2048, 128}; pg8::StaticOrder S; S.init(SEQ, 2048, id.G, id.bx); EpiUkv E{Qm + (size_t)SEQ * 1536, Qm + (size_t)SEQ * 2560, (const float*)(ws + WS_SSKV)};
            GEMM_PHASE(EpiUkv, lds, g, S, E); } }
#endif
        SEAM(pb + 3);
#if PH&8
        if (IN(pb + 4))
        { KARGS(ka); const Ids id = get_ids(); unsigned char* ws = ka->ws; const bf16_t* Qm = (const bf16_t*)(ws + WS_BIG);
          for (int i = 0; i < 4; ++i)
            for (int v = id.vcu; v < 256; v += id.G) { const int s = v & 15, hd = v >> 4; const int qb = i == 0 ? 63 - s : i == 1 ? 32 + s : i == 2 ? 31 - s : s;
                mla_unit(hd, qb, Qm, Qm + (size_t)SEQ * 1536, (const bf16_t*)(ws + WS_KR), Qm + (size_t)SEQ * 2560, (bf16_t*)(ws + WS_ZM), (LAS char*)lds); }
        }
#endif
        SEAM(pb + 4);
#if PH&16
        if (IN(pb + 5))
        { KARGS(ka); const Ids id = get_ids(); unsigned char* ws = ka->ws; bf16_t* MERGED = (bf16_t*)(ws + WS_BIG);
          const bf16_t* H = (const bf16_t*)(ws + WS_H); const bf16_t* WIN = (const bf16_t*)(ws + WS_WIN);
          for (int un = id.vcu; un < 1024; un += id.G) p4_unit(un >> 3, un & 7, H, (const bf16_t*)(ws + WS_ZA), (const bf16_t*)(ws + WS_ZM), WIN + (size_t)6656 * 1024, WIN + (size_t)7680 * 1024, (const bf16_t*)(ws + WS_WA), (const bf16_t*)(ws + WS_WB), MERGED, (LAS char*)lds); }
#endif
        SEAM(pb + 5);
#if PH&32
        if (IN(pb + 6))
        { KARGS(ka); const Ids id = get_ids(); unsigned char* ws = ka->ws;
          pg8::Gemm g{(const bf16_t*)(ws + WS_BIG), (const bf16_t*)(ws + WS_WO), SEQ, 1024, 1024}; pg8::StaticOrder S; S.init(SEQ, 1024, id.G, id.bx);
          EpiRes E{layer == 0 ? ka->in[0] : (const float*)ka->out, ka->out, (const float*)(ws + WS_MOD) + layer * 3072 + 2048};
          GEMM_PHASE(EpiRes, lds, g, S, E); }
#endif
        SEAM(pb + 6);
    }
    if (IN(15)) { KARGS(ka); FRESH_TID(); const Ids id = get_ids(); final_rows(ka->out, ka->in[15], id.vcu * NWAVES + wave, id.G * NWAVES, lane); }
}


extern "C" void kernel_launch(void* const* d_in, const int* in_sizes, int n_in, void* d_out, int out_size, void* d_ws, size_t ws_size, hipStream_t stream) {
    static int grid = 0;
    if (grid == 0) {
        if (n_in != 16 || out_size != SEQ * DM || ws_size < WS_END) { fprintf(stderr, "kernel_launch: unexpected problem: n_in %d out %d ws %zu (need %zu)\n", n_in, out_size, ws_size, (size_t)WS_END); grid = -1; return; }
        int dev = 0, cus = 0, per_cu = 0;
        if (hipGetDevice(&dev) != hipSuccess || hipDeviceGetAttribute(&cus, hipDeviceAttributeMultiprocessorCount, dev) != hipSuccess) { grid = -1; return; }
        if (hipFuncSetAttribute((const void*)fwd_mega, hipFuncAttributeMaxDynamicSharedMemorySize, LDS_BYTES) != hipSuccess) { fprintf(stderr, "kernel_launch: hipFuncSetAttribute failed\n"); grid = -1; return; }
        if (hipOccupancyMaxActiveBlocksPerMultiprocessor(&per_cu, (const void*)fwd_mega, NWAVES * 64, LDS_BYTES) != hipSuccess || per_cu < 1) fprintf(stderr, "kernel_launch: occupancy query says %d\n", per_cu);
        (void)hipGetLastError();
        grid = cus;
    }
    if (grid < 0) return;
    if (hipMemsetAsync((char*)d_ws + WS_BAR, 0, 16384, stream) != hipSuccess) { fprintf(stderr, "kernel_launch: memset failed\n"); return; }
    Args a{};
    for (int i = 0; i < 16; ++i) a.in[i] = (const float*)d_in[i];
    a.out = (float*)d_out; a.ws = (unsigned char*)d_ws;
#if N_LAUNCH == 1
    a.ph_lo = 0; a.ph_hi = 16;
    void* args[] = {&a};
    hipError_t e = hipLaunchCooperativeKernel((const void*)fwd_mega, dim3(grid), dim3(NWAVES * 64), args, LDS_BYTES, stream);
    if (e != hipSuccess) fprintf(stderr, "kernel_launch: cooperative launch failed: %s (grid %d)\n", hipGetErrorString(e), grid);
#else
    for (int p = 0; p < 16; ++p) { a.ph_lo = p; a.ph_hi = p + 1; hipLaunchKernelGGL(fwd_mega, dim3(grid), dim3(NWAVES * 64), LDS_BYTES, stream, a); }
#endif
}
```

```cpp
#include <hip/hip_runtime.h>
#include <hip/hip_cooperative_groups.h>
#include <cstdio>
#include <cstdint>
namespace cg = cooperative_groups;
#ifndef N_LAUNCH
#define N_LAUNCH 1
#endif
#ifndef PH
#define PH 63
#endif
namespace pg8 {
#define PG8_LAS __attribute__((address_space(3)))
typedef unsigned short bf16_t;
typedef short bf16x8 __attribute__((ext_vector_type(8)));
typedef float f32x4 __attribute__((ext_vector_type(4)));
typedef unsigned u32x4 __attribute__((ext_vector_type(4)));
constexpr int BM = 256, BK = 64, HALF = 128, HTB = HALF * BK * 2  , STAGE_BYTES = 8 * HTB, NXCD = 8, WGM = 8;

__host__ __device__ __forceinline__ int lds_byte(int r, int c) { const int st = (r >> 4) * 2 + (c >> 5), rr = r & 15, cc = c & 31, ob = rr * 64 + cc * 2; return st * 1024 + (ob ^ (((ob >> 9) & 1) << 5)); }
__host__ __device__ __forceinline__ void stage_rc(int b, int& R, int& C) { const int st = b / 1024, sb = b % 1024, swz = sb ^ (((sb >> 9) & 1) << 5); R = (st >> 1) * 16 + swz / 64; C = (st & 1) * 32 + (swz % 64) / 2; }
__host__ __device__ __forceinline__ int perm32(int rho) { const int n = rho >> 4, i = rho & 15; return 8 * (i >> 2) + 4 * n + (i & 3); }

struct Unit { int pm, pn; };
struct Gemm { const bf16_t* A; const bf16_t* Bt; int M, N, K; };

struct StaticOrder {
    int nM, nN, nwg, G, c;
    __host__ __device__ void init(int M, int N, int G_, int c_) { nM = M / BM; nN = N / BM; nwg = nM * nN; G = G_; c = c_; }
    __host__ __device__ bool next(int i, Unit& u) const {
        const long L = (long)i * G + c; if (L >= nwg) return false;
        int wgid = (int)L; { const int q = nwg / NXCD, r = nwg % NXCD, xcd = wgid % NXCD, off = wgid / NXCD; wgid = (xcd < r ? xcd * (q + 1) : r * (q + 1) + (xcd - r) * q) + off; }
        const int nig = WGM * nN, gid = wgid / nig, fm = gid * WGM, gsz = (nM - fm) < WGM ? (nM - fm) : WGM;
        u.pm = fm + ((wgid % nig) % gsz); u.pn = (wgid % nig) / gsz; return true;
    }
    __device__ __forceinline__ void a_ready(const Unit&) const {}
    __device__ __forceinline__ void done(const Unit&) const {}
};

__device__ __forceinline__ unsigned cvt_pk_bf16(float lo, float hi) { unsigned r; asm volatile("v_cvt_pk_bf16_f32 %0, %1, %2" : "=v"(r) : "v"(lo), "v"(hi)); return r; }
template <class Epi, class Sched, bool ALIGN_EPI = false, bool SP2 = false>
__device__ __forceinline__ void gemm_phase(PG8_LAS unsigned char* lds, const Gemm g, const Sched& S, const Epi& E) {
    int tid_ = threadIdx.x; asm volatile("" : "+v"(tid_));
    const int tid = tid_, wid = __builtin_amdgcn_readfirstlane(tid >> 6), lane = tid & 63, wr = wid >> 2, wc = wid & 3, fr = lane & 15, fq = lane >> 4;
    int K_ = g.K; asm volatile("" : "+s"(K_)); const int K = K_, nt = K / BK;
    unsigned voffA[2], voffB[2];
#pragma unroll
    for (int i = 0; i < 2; ++i) { int R, C; stage_rc(tid * 16 + i * 8192, R, C); const int Rb = Epi::PERM ? ((R & ~31) + perm32(R & 31)) : R;
        voffA[i] = (unsigned)(R * K + C) * 2u; voffB[i] = (unsigned)(Rb * K + C) * 2u; }
    const size_t kstep = (size_t)(BK * 2);
    const size_t hstep = (size_t)HALF * K * 2;
    const size_t tstep = 2 * hstep;
    const unsigned ldsw = (unsigned)wid * 1024u;
    const int aoff = lds_byte(wr * 64 + fr, fq * 8), boff = lds_byte(wc * 32 + fr, fq * 8);
#define PG8_SA(b, h) (((b) * 2 + (h)) * HTB)
#define PG8_SB(b, h) ((4 + (b) * 2 + (h)) * HTB)
#define PG8_STAGE(bufoff, gbase, voff) do { _Pragma("unroll") for (int _i = 0; _i < 2; ++_i) \
        __builtin_amdgcn_global_load_lds((const unsigned*)((const char*)(gbase) + (voff)[_i]), (PG8_LAS unsigned*)(lds + (bufoff) + ldsw + _i * 8192), 16, 0, 0); } while (0)
#define PG8_LDA(dst, b, h) do { _Pragma("unroll") for (int m = 0; m < 4; ++m) _Pragma("unroll") for (int k = 0; k < 2; ++k) dst[m][k] = *(const PG8_LAS bf16x8*)(lds + PG8_SA(b, h) + aoff + m * 2048 + k * 1024); } while (0)
#define PG8_LDB(dst, b, h) do { _Pragma("unroll") for (int n = 0; n < 2; ++n) _Pragma("unroll") for (int k = 0; k < 2; ++k) dst[n][k] = *(const PG8_LAS bf16x8*)(lds + PG8_SB(b, h) + boff + n * 2048 + k * 1024); } while (0)
#define PG8_MMA(ai, bj, At, Bt) do { __builtin_amdgcn_s_setprio(1); _Pragma("unroll") for (int m = 0; m < 4; ++m) _Pragma("unroll") for (int n = 0; n < 2; ++n) _Pragma("unroll") for (int k = 0; k < 2; ++k) \
        acc[ai][bj][m][n] = __builtin_amdgcn_mfma_f32_16x16x32_bf16(Bt[n][k], At[m][k], acc[ai][bj][m][n], 0, 0, 0); __builtin_amdgcn_s_setprio(0); } while (0)
#define PG8_WAIT_V(n) asm volatile("s_waitcnt vmcnt(" #n ")" ::: "memory")
#define PG8_WAIT_L(n) asm volatile("s_waitcnt lgkmcnt(" #n ")" ::: "memory")
#define PG8_BAR __builtin_amdgcn_s_barrier()
#define PG8_SCHED __builtin_amdgcn_sched_barrier(0)
    Unit cur, nxt; int ui = 0;
    if (!S.next(0, cur)) return;
    f32x4 acc[2][2][4][2];
#pragma unroll
    for (int a = 0; a < 2; ++a)
#pragma unroll
        for (int b = 0; b < 2; ++b)
#pragma unroll
            for (int m = 0; m < 4; ++m)
#pragma unroll
                for (int n = 0; n < 2; ++n) acc[a][b][m][n] = (f32x4){0.f, 0.f, 0.f, 0.f};
    bf16x8 At[4][2], B0[2][2], B1[2][2];
    const char* cA = (const char*)g.A + (size_t)cur.pm * tstep; const char* cB = (const char*)g.Bt + (size_t)cur.pn * tstep;
    S.a_ready(cur);
    if constexpr (SP2) {
        PG8_STAGE(PG8_SB(0, 0), cB, voffB); PG8_STAGE(PG8_SB(0, 1), cB + hstep, voffB); PG8_STAGE(PG8_SA(0, 0), cA, voffA); PG8_STAGE(PG8_SA(0, 1), cA + hstep, voffA);
        if (wr == 1) PG8_BAR;
        PG8_WAIT_V(2); PG8_BAR;
        PG8_STAGE(PG8_SB(1, 0), cB + kstep, voffB); PG8_STAGE(PG8_SA(1, 0), cA + kstep, voffA); PG8_STAGE(PG8_SB(1, 1), cB + hstep + kstep, voffB);
        PG8_WAIT_V(6); PG8_BAR;
    } else {
        PG8_STAGE(PG8_SB(0, 0), cB, voffB); PG8_STAGE(PG8_SA(0, 0), cA, voffA); PG8_STAGE(PG8_SB(0, 1), cB + hstep, voffB); PG8_STAGE(PG8_SA(0, 1), cA + hstep, voffA);
        if (wr == 1) PG8_BAR;
        PG8_WAIT_V(4); PG8_BAR;
        PG8_STAGE(PG8_SB(1, 0), cB + kstep, voffB); PG8_STAGE(PG8_SA(1, 0), cA + kstep, voffA); PG8_STAGE(PG8_SB(1, 1), cB + hstep + kstep, voffB);
        PG8_WAIT_V(6); PG8_BAR;
    }
    for (;;) {
        const bool has_next = S.next(ui + 1, nxt);
        const char* nA = has_next ? (const char*)g.A + (size_t)nxt.pm * tstep : cA; const char* nB = has_next ? (const char*)g.Bt + (size_t)nxt.pn * tstep : cB;
        for (int t = 0; t < nt; t += 2) {
            const bool last = (t == nt - 2);
            const char* a1 = cA + (size_t)(t + 1) * kstep;
            const char* a2 = last ? nA : cA + (size_t)(t + 2) * kstep; const char* b2 = last ? nB : cB + (size_t)(t + 2) * kstep;
            const char* a3 = a2 + kstep; const char* b3 = b2 + kstep;
            if (last && has_next) S.a_ready(nxt);
            if constexpr (SP2) {
            PG8_LDB(B0, 0, 0); PG8_LDB(B1, 0, 1); PG8_SCHED; PG8_LDA(At, 0, 0); PG8_STAGE(PG8_SA(1, 1), a1 + hstep, voffA);
            PG8_WAIT_V(8); PG8_WAIT_L(0); PG8_BAR; PG8_MMA(0, 0, At, B0); PG8_MMA(0, 1, At, B1); PG8_BAR; PG8_SCHED;
            PG8_LDA(At, 0, 1); PG8_STAGE(PG8_SB(0, 0), b2, voffB); PG8_STAGE(PG8_SB(0, 1), b2 + hstep, voffB); PG8_STAGE(PG8_SA(0, 0), a2, voffA);
            PG8_WAIT_V(8); PG8_WAIT_L(0); PG8_BAR; PG8_MMA(1, 0, At, B0); PG8_MMA(1, 1, At, B1); PG8_BAR; PG8_SCHED;
            PG8_LDB(B0, 1, 0); PG8_LDB(B1, 1, 1); PG8_SCHED; PG8_LDA(At, 1, 0); PG8_STAGE(PG8_SA(0, 1), a2 + hstep, voffA);
            PG8_WAIT_V(8); PG8_WAIT_L(0); PG8_BAR; PG8_MMA(0, 0, At, B0); PG8_MMA(0, 1, At, B1); PG8_BAR; PG8_SCHED;
            PG8_LDA(At, 1, 1); PG8_STAGE(PG8_SB(1, 0), b3, voffB); PG8_STAGE(PG8_SB(1, 1), b3 + hstep, voffB); PG8_STAGE(PG8_SA(1, 0), a3, voffA);
            PG8_WAIT_V(8); PG8_WAIT_L(0); PG8_BAR; PG8_MMA(1, 0, At, B0); PG8_MMA(1, 1, At, B1); PG8_BAR; PG8_SCHED;
            } else {
            PG8_LDB(B0, 0, 0); PG8_SCHED; PG8_LDA(At, 0, 0); PG8_STAGE(PG8_SA(1, 1), a1 + hstep, voffA);
            PG8_WAIT_L(8); PG8_BAR; PG8_WAIT_L(0); PG8_MMA(0, 0, At, B0); PG8_BAR; PG8_SCHED;
            PG8_LDB(B1, 0, 1); PG8_STAGE(PG8_SB(0, 0), b2, voffB);
            PG8_BAR; PG8_WAIT_L(0); PG8_MMA(0, 1, At, B1); PG8_BAR;
            PG8_LDA(At, 0, 1); PG8_STAGE(PG8_SA(0, 0), a2, voffA);
            PG8_BAR; PG8_WAIT_L(0); PG8_MMA(1, 0, At, B0); PG8_BAR; PG8_SCHED;
            PG8_STAGE(PG8_SB(0, 1), b2 + hstep, voffB);
            PG8_WAIT_V(6); PG8_BAR; PG8_MMA(1, 1, At, B1); PG8_BAR;
            PG8_LDB(B0, 1, 0); PG8_SCHED; PG8_LDA(At, 1, 0); PG8_STAGE(PG8_SA(0, 1), a2 + hstep, voffA);
            PG8_WAIT_L(8); PG8_BAR; PG8_WAIT_L(0); PG8_MMA(0, 0, At, B0); PG8_BAR; PG8_SCHED;
            PG8_LDB(B1, 1, 1); PG8_STAGE(PG8_SB(1, 0), b3, voffB);
            PG8_BAR; PG8_WAIT_L(0); PG8_MMA(0, 1, At, B1); PG8_BAR;
            PG8_LDA(At, 1, 1); PG8_STAGE(PG8_SA(1, 0), a3, voffA);
            PG8_BAR; PG8_WAIT_L(0); PG8_MMA(1, 0, At, B0); PG8_BAR; PG8_SCHED;
            PG8_STAGE(PG8_SB(1, 1), b3 + hstep, voffB);
            PG8_WAIT_V(6); PG8_BAR; PG8_MMA(1, 1, At, B1); PG8_BAR;
            }
        }
        if constexpr (ALIGN_EPI) { if (wr == 0) PG8_BAR; }
        if constexpr (!Epi::AFTER_DRAIN) { E(acc, cur, wr, wc, fr, fq); S.done(cur); }
        if (!has_next) break;
#pragma unroll
        for (int a = 0; a < 2; ++a)
#pragma unroll
            for (int b = 0; b < 2; ++b)
#pragma unroll
                for (int m = 0; m < 4; ++m)
#pragma unroll
                    for (int n = 0; n < 2; ++n) acc[a][b][m][n] = (f32x4){0.f, 0.f, 0.f, 0.f};
        cur = nxt; cA = nA; cB = nB; ++ui;
        if constexpr (ALIGN_EPI) { if (wr == 1) PG8_BAR; }
    }
    PG8_WAIT_V(0);
    if constexpr (!ALIGN_EPI) { if (wr == 0) PG8_BAR; }
    PG8_BAR;
    if constexpr (Epi::AFTER_DRAIN) { E.fused(acc, cur, wr, wc, fr, fq, lds, wid, lane); S.done(cur); }
#undef PG8_SA
#undef PG8_SB
#undef PG8_STAGE
#undef PG8_LDA
#undef PG8_LDB
#undef PG8_MMA
#undef PG8_WAIT_V
#undef PG8_WAIT_L
#undef PG8_BAR
#undef PG8_SCHED
}
}

#define LAS __attribute__((address_space(3)))
typedef unsigned short bf16_t;
typedef short bf16x8 __attribute__((ext_vector_type(8)));
typedef short s16x4 __attribute__((ext_vector_type(4)));
typedef float f32x4 __attribute__((ext_vector_type(4)));
typedef float f32x16 __attribute__((ext_vector_type(16)));
typedef unsigned u32x4 __attribute__((ext_vector_type(4)));
typedef unsigned u32x2 __attribute__((ext_vector_type(2)));

constexpr int SEQ = 16384, DM = 1024, DIN = 8608, NWAVES = 8;
constexpr float LOG2E = 1.4426950408889634f;
constexpr float EPS = 1e-6f;
constexpr float NEGB = -1e30f;
constexpr size_t MiB = 1u << 20;
constexpr size_t WS_WIN = 0;
constexpr size_t WS_WUQ = WS_WIN + (size_t)8704 * 1024 * 2;
constexpr size_t WS_WUKV = WS_WUQ + (size_t)1536 * 256 * 2;
constexpr size_t WS_WA = WS_WUKV + (size_t)2048 * 128 * 2;
constexpr size_t WS_WB = WS_WA + (size_t)1024 * 512 * 2;
constexpr size_t WS_WO = WS_WB + (size_t)1024 * 1024 * 2;
static_assert(WS_WO + (size_t)1024 * 1024 * 2 <= 24 * MiB, "weights region");
constexpr size_t WS_MOD = 24 * MiB;
constexpr size_t WS_BT = WS_MOD + 32768;
constexpr size_t WS_SSQ = WS_BT + 32768;
constexpr size_t WS_SSKV = WS_SSQ + (size_t)SEQ * 16;
constexpr size_t WS_COS = 25 * MiB;
constexpr size_t WS_SIN = 26 * MiB;
constexpr size_t WS_H = 27 * MiB;
constexpr size_t WS_ZA = WS_H + 32 * MiB;
constexpr size_t WS_ZM = WS_ZA + 16 * MiB;
constexpr size_t WS_CQ = WS_ZM + 32 * MiB;
constexpr size_t WS_CKV = WS_CQ + 8 * MiB;
constexpr size_t WS_KR = WS_CKV + 4 * MiB;
constexpr size_t WS_BIG = WS_KR + 1 * MiB;
constexpr size_t WS_END = WS_BIG + 144 * MiB;
constexpr size_t GSZ = (size_t)SEQ * 512;
constexpr int LDS_BYTES = 147456;
constexpr size_t WS_BAR = WS_MOD + 640 * 1024;
constexpr int LDS_ST = 139264;

__device__ __forceinline__ float fast_exp2(float x) { return __builtin_amdgcn_exp2f(x); }
__device__ __forceinline__ float fast_rcp(float x) { return __builtin_amdgcn_rcpf(x); }
__device__ __forceinline__ float silu_f(float v) { return v * fast_rcp(1.f + fast_exp2(-v * LOG2E)); }
__device__ __forceinline__ float sigm_f(float v) { return fast_rcp(1.f + fast_exp2(-v * LOG2E)); }
__device__ __forceinline__ float bf2f(unsigned short b) { return __uint_as_float((unsigned)b << 16); }
__device__ __forceinline__ float bflo(unsigned w) { return __uint_as_float(w << 16); }
__device__ __forceinline__ float bfhi(unsigned w) { return __uint_as_float(w & 0xffff0000u); }
using pg8::cvt_pk_bf16;
__device__ __forceinline__ u32x4 pack8(const f32x4& a, const f32x4& b) { u32x4 w; w.x = cvt_pk_bf16(a[0], a[1]); w.y = cvt_pk_bf16(a[2], a[3]); w.z = cvt_pk_bf16(b[0], b[1]); w.w = cvt_pk_bf16(b[2], b[3]); return w; }

struct EpiIn {
    static constexpr bool PERM = true, AFTER_DRAIN = false;
    bf16_t* BIG; bf16_t* ZA; bf16_t* ZM; bf16_t* CQ; bf16_t* CKV; bf16_t* KR; float* SSQ; float* SSKV; const float* COS; const float* SIN;
    __device__ __forceinline__ void operator()(const f32x4 (&acc)[2][2][4][2], const pg8::Unit& u, int wr, int wc, int fr, int fq) const {
        const int pn = u.pn; const int rowb = u.pm * 256 + wr * 64 + fr; const int cb = wc * 32 + 8 * fq;
        if (pn < 18) {
            const int which = pn / 6, g = (pn % 6) >> 1, half = pn & 1, sh = 2 * g;
            bf16_t* base = BIG + (size_t)(which * 3 + g) * GSZ + half * 256 + cb;
            const float sc = which == 0 ? 0.125f * LOG2E : 1.f;
#pragma unroll
            for (int ai = 0; ai < 2; ++ai)
#pragma unroll
                for (int m = 0; m < 4; ++m) { const int t = rowb + ai * 128 + m * 16; const int rho = (t & ((1 << sh) - 1)) * (SEQ >> sh) + (t >> sh);
#pragma unroll
                    for (int bj = 0; bj < 2; ++bj) *(u32x4*)(base + (size_t)rho * 512 + bj * 128) = pack8(acc[ai][bj][m][0] * sc, acc[ai][bj][m][1] * sc); }
        } else if (pn < 20 || pn >= 22) {
            bf16_t* base = pn < 20 ? ZA + (pn - 18) * 256 + cb : ZM + (pn - 22) * 256 + cb; const int ld = pn < 20 ? 512 : 1024;
#pragma unroll
            for (int ai = 0; ai < 2; ++ai)
#pragma unroll
                for (int m = 0; m < 4; ++m) { const int t = rowb + ai * 128 + m * 16;
#pragma unroll
                    for (int bj = 0; bj < 2; ++bj) { f32x4 a = acc[ai][bj][m][0], b = acc[ai][bj][m][1];
#pragma unroll
                        for (int j = 0; j < 4; ++j) { a[j] = silu_f(a[j]); b[j] = silu_f(b[j]); }
                        *(u32x4*)(base + (size_t)t * ld + bj * 128) = pack8(a, b); } }
        } else if (pn == 20) {
#pragma unroll
            for (int ai = 0; ai < 2; ++ai)
#pragma unroll
                for (int m = 0; m < 4; ++m) { const int t = rowb + ai * 128 + m * 16; float s = 0.f;
#pragma unroll
                    for (int bj = 0; bj < 2; ++bj) { const f32x4 a = acc[ai][bj][m][0], b = acc[ai][bj][m][1];
                        s += (a[0] * a[0] + a[1] * a[1]) + (a[2] * a[2] + a[3] * a[3]) + (b[0] * b[0] + b[1] * b[1]) + (b[2] * b[2] + b[3] * b[3]);
                        *(u32x4*)(CQ + (size_t)t * 256 + bj * 128 + cb) = pack8(a, b); }
                    s += __shfl_xor(s, 16); s += __shfl_xor(s, 32);
                    if (fq == 0) SSQ[(size_t)t * 4 + wc] = s; }
        } else {
#pragma unroll
            for (int ai = 0; ai < 2; ++ai)
#pragma unroll
                for (int m = 0; m < 4; ++m) { const int t = rowb + ai * 128 + m * 16;
                    const f32x4 a = acc[ai][0][m][0], b = acc[ai][0][m][1];
                    float s = (a[0] * a[0] + a[1] * a[1]) + (a[2] * a[2] + a[3] * a[3]) + (b[0] * b[0] + b[1] * b[1]) + (b[2] * b[2] + b[3] * b[3]);
                    *(u32x4*)(CKV + (size_t)t * 128 + cb) = pack8(a, b);
                    s += __shfl_xor(s, 16); s += __shfl_xor(s, 32);
                    if (fq == 0) SSKV[(size_t)t * 4 + wc] = s;
                    if (wc == 0) { const f32x4 t1 = acc[ai][1][m][0], t2 = acc[ai][1][m][1];
                        const f32x4 c = *(const f32x4*)(COS + (size_t)t * 16 + 4 * fq), sn = *(const f32x4*)(SIN + (size_t)t * 16 + 4 * fq);
                        const f32x4 o1 = t1 * c - t2 * sn, o2 = t1 * sn + t2 * c;
                        u32x2 w1, w2; w1.x = cvt_pk_bf16(o1[0], o1[1]); w1.y = cvt_pk_bf16(o1[2], o1[3]); w2.x = cvt_pk_bf16(o2[0], o2[1]); w2.y = cvt_pk_bf16(o2[2], o2[3]);
                        *(u32x2*)(KR + (size_t)t * 32 + 4 * fq) = w1; *(u32x2*)(KR + (size_t)t * 32 + 16 + 4 * fq) = w2; }
                    asm volatile("" ::: "memory"); }
        }
    }
};
struct EpiUq {
    static constexpr bool PERM = true, AFTER_DRAIN = false;
    bf16_t* Qm; const float* SSQ; const float* COS; const float* SIN;
    __device__ __forceinline__ void operator()(const f32x4 (&acc)[2][2][4][2], const pg8::Unit& u, int wr, int wc, int fr, int fq) const {
        const int pn = u.pn; const int rowb = u.pm * 256 + wr * 64 + fr;
        const float C2 = 0.10206207261596577f * LOG2E;
#pragma unroll
        for (int ai = 0; ai < 2; ++ai)
#pragma unroll
            for (int m = 0; m < 4; ++m) { const int t = rowb + ai * 128 + m * 16;
                const f32x4 ss = *(const f32x4*)(SSQ + (size_t)t * 4);
                const float f = __builtin_amdgcn_rsqf(((ss[0] + ss[1]) + (ss[2] + ss[3])) * (1.f / 256.f) + EPS) * C2;
                if (pn < 4) {
#pragma unroll
                    for (int bj = 0; bj < 2; ++bj) { const int gc = pn * 256 + bj * 128 + wc * 32 + 8 * fq;
                        *(u32x4*)(Qm + (size_t)t * 1536 + (gc >> 6) * 96 + (gc & 63)) = pack8(acc[ai][bj][m][0] * f, acc[ai][bj][m][1] * f); }
                } else {
                    const f32x4 c = *(const f32x4*)(COS + (size_t)t * 16 + 4 * fq), sn = *(const f32x4*)(SIN + (size_t)t * 16 + 4 * fq);
#pragma unroll
                    for (int bj = 0; bj < 2; ++bj) { const int head = (pn - 4) * 8 + bj * 4 + wc;
                        const f32x4 t1 = acc[ai][bj][m][0] * f, t2 = acc[ai][bj][m][1] * f;
                        const f32x4 o1 = t1 * c - t2 * sn, o2 = t1 * sn + t2 * c;
                        u32x2 w1, w2; w1.x = cvt_pk_bf16(o1[0], o1[1]); w1.y = cvt_pk_bf16(o1[2], o1[3]); w2.x = cvt_pk_bf16(o2[0], o2[1]); w2.y = cvt_pk_bf16(o2[2], o2[3]);
                        bf16_t* p = Qm + (size_t)t * 1536 + head * 96 + 64 + 4 * fq;
                        *(u32x2*)p = w1; *(u32x2*)(p + 16) = w2; }
                }
                asm volatile("" ::: "memory"); }
    }
};
struct EpiUkv {
    static constexpr bool PERM = true, AFTER_DRAIN = false;
    bf16_t* Km; bf16_t* Vm; const float* SSKV;
    __device__ __forceinline__ void operator()(const f32x4 (&acc)[2][2][4][2], const pg8::Unit& u, int wr, int wc, int fr, int fq) const {
        const int pn = u.pn; const int rowb = u.pm * 256 + wr * 64 + fr; const int cb = wc * 32 + 8 * fq;
        bf16_t* base = (pn < 4 ? Km + pn * 256 : Vm + (pn - 4) * 256) + cb;
#pragma unroll
        for (int ai = 0; ai < 2; ++ai)
#pragma unroll
            for (int m = 0; m < 4; ++m) { const int t = rowb + ai * 128 + m * 16;
                const f32x4 ss = *(const f32x4*)(SSKV + (size_t)t * 4);
                const float f = __builtin_amdgcn_rsqf(((ss[0] + ss[1]) + (ss[2] + ss[3])) * (1.f / 128.f) + EPS);
#pragma unroll
                for (int bj = 0; bj < 2; ++bj) *(u32x4*)(base + (size_t)t * 1024 + bj * 128) = pack8(acc[ai][bj][m][0] * f, acc[ai][bj][m][1] * f);
                if (m & 1) asm volatile("" ::: "memory"); }
    }
};
struct EpiRes {
    static constexpr bool PERM = false, AFTER_DRAIN = false;
    const float* xin; float* out; const float* gate;
    __device__ __forceinline__ void operator()(const f32x4 (&acc)[2][2][4][2], const pg8::Unit& u, int wr, int wc, int fr, int fq) const {
        const int rowb = u.pm * 256 + wr * 64 + fr; const int c0 = u.pn * 256 + wc * 32 + 4 * fq;
        f32x4 gv[2][2];
#pragma unroll
        for (int bj = 0; bj < 2; ++bj)
#pragma unroll
            for (int n = 0; n < 2; ++n) gv[bj][n] = *(const f32x4*)(gate + c0 + bj * 128 + n * 16);
#pragma unroll
        for (int ai = 0; ai < 2; ++ai)
#pragma unroll
            for (int m = 0; m < 4; ++m) { const int t = rowb + ai * 128 + m * 16;
#pragma unroll
                for (int bj = 0; bj < 2; ++bj)
#pragma unroll
                    for (int n = 0; n < 2; ++n) { const size_t off = (size_t)t * 1024 + c0 + bj * 128 + n * 16;
                        const f32x4 xv = *(const f32x4*)(xin + off); *(f32x4*)(out + off) = xv + gv[bj][n] * acc[ai][bj][m][n]; }
                if (m & 1) asm volatile("" ::: "memory"); }
    }
};


#define GEMM_PHASE(EPI, lds, g, S, E) pg8::gemm_phase<EPI, pg8::StaticOrder, true, true>(lds, g, S, E)


constexpr int P4_PITCH = 144, P4_OPB = 128 * P4_PITCH, P4_BUF = 2 * P4_OPB;
__device__ __forceinline__ void p4_pass(const bf16_t* __restrict__ A, int K, const bf16_t* __restrict__ B, int rt, int ct, f32x16& c0, f32x16& c1, LAS char* lds, int tid, int r32, int hi, int wa, int wb) {
    const bf16_t* asrc = A + (size_t)(rt * 128 + (tid >> 2)) * K + (tid & 3) * 8;
    const bf16_t* bsrc = B + (size_t)(ct * 128 + (tid >> 2)) * K + (tid & 3) * 8;
    const int sdst = (tid >> 2) * P4_PITCH + (tid & 3) * 16;
    const int xoff = (wa * 32 + r32) * P4_PITCH + hi * 16, woff = P4_OPB + (wb * 64 + r32) * P4_PITCH + hi * 16;
    const int nk = K >> 6;
    u32x4 ga0 = *(const u32x4*)asrc, ha0 = *(const u32x4*)(asrc + 32), gb0 = *(const u32x4*)bsrc, hb0 = *(const u32x4*)(bsrc + 32), ga1, ha1, gb1, hb1;
    *(LAS u32x4*)(lds + sdst) = ga0; *(LAS u32x4*)(lds + sdst + 64) = ha0; *(LAS u32x4*)(lds + P4_OPB + sdst) = gb0; *(LAS u32x4*)(lds + P4_OPB + sdst + 64) = hb0;
    ga1 = *(const u32x4*)(asrc + 64); ha1 = *(const u32x4*)(asrc + 96); gb1 = *(const u32x4*)(bsrc + 64); hb1 = *(const u32x4*)(bsrc + 96);
    __syncthreads();
    c0 = (f32x16){}; c1 = (f32x16){};
#define P4_STEP(kt, GA_LD, HA_LD, GB_LD, HB_LD, GA_ST, HA_ST, GB_ST, HB_ST) do { \
        const LAS char* buf = lds + ((kt) & 1) * P4_BUF; \
        if ((kt) + 2 < nk) { GA_LD = *(const u32x4*)(asrc + ((kt) + 2) * 64); HA_LD = *(const u32x4*)(asrc + ((kt) + 2) * 64 + 32); GB_LD = *(const u32x4*)(bsrc + ((kt) + 2) * 64); HB_LD = *(const u32x4*)(bsrc + ((kt) + 2) * 64 + 32); } \
        _Pragma("unroll") for (int s = 0; s < 4; ++s) { \
            const bf16x8 x = *(const LAS bf16x8*)(buf + xoff + s * 32); \
            const bf16x8 w0 = *(const LAS bf16x8*)(buf + woff + s * 32), w1 = *(const LAS bf16x8*)(buf + woff + 32 * P4_PITCH + s * 32); \
            c0 = __builtin_amdgcn_mfma_f32_32x32x16_bf16(w0, x, c0, 0, 0, 0); c1 = __builtin_amdgcn_mfma_f32_32x32x16_bf16(w1, x, c1, 0, 0, 0); } \
        if ((kt) + 1 < nk) { LAS char* nb = lds + (((kt) + 1) & 1) * P4_BUF; *(LAS u32x4*)(nb + sdst) = GA_ST; *(LAS u32x4*)(nb + sdst + 64) = HA_ST; *(LAS u32x4*)(nb + P4_OPB + sdst) = GB_ST; *(LAS u32x4*)(nb + P4_OPB + sdst + 64) = HB_ST; } \
        __syncthreads(); } while (0)
    for (int kt = 0; kt < nk; kt += 2) {
        P4_STEP(kt, ga0, ha0, gb0, hb0, ga1, ha1, gb1, hb1);
        P4_STEP(kt + 1, ga1, ha1, gb1, hb1, ga0, ha0, gb0, hb0);
    }
#undef P4_STEP
}
constexpr int P4_BUF2 = 3 * P4_OPB;
__device__ __forceinline__ void p4_pass2(const bf16_t* __restrict__ A, int K, const bf16_t* __restrict__ B0, const bf16_t* __restrict__ B1, int rt, int ct, f32x16& a0, f32x16& a1, f32x16& m0, f32x16& m1, LAS char* lds, int tid, int r32, int hi, int wa, int wb) {
    const bf16_t* asrc = A + (size_t)(rt * 128 + (tid >> 2)) * K + (tid & 3) * 8;
    const bf16_t* bsrc = B0 + (size_t)(ct * 128 + (tid >> 2)) * K + (tid & 3) * 8;
    const bf16_t* csrc = B1 + (size_t)(ct * 128 + (tid >> 2)) * K + (tid & 3) * 8;
    const int sdst = (tid >> 2) * P4_PITCH + (tid & 3) * 16;
    const int xoff = (wa * 32 + r32) * P4_PITCH + hi * 16, woff = P4_OPB + (wb * 64 + r32) * P4_PITCH + hi * 16;
    const int nk = K >> 6;
    u32x4 rA[6], rB[6];
#define P4_LD2(kt, R) do { R[0] = *(const u32x4*)(asrc + (kt) * 64); R[1] = *(const u32x4*)(asrc + (kt) * 64 + 32); R[2] = *(const u32x4*)(bsrc + (kt) * 64); R[3] = *(const u32x4*)(bsrc + (kt) * 64 + 32); \
        R[4] = *(const u32x4*)(csrc + (kt) * 64); R[5] = *(const u32x4*)(csrc + (kt) * 64 + 32); } while (0)
#define P4_ST2(boff, R) do { LAS char* nb_ = lds + (boff); *(LAS u32x4*)(nb_ + sdst) = R[0]; *(LAS u32x4*)(nb_ + sdst + 64) = R[1]; *(LAS u32x4*)(nb_ + P4_OPB + sdst) = R[2]; *(LAS u32x4*)(nb_ + P4_OPB + sdst + 64) = R[3]; \
        *(LAS u32x4*)(nb_ + 2 * P4_OPB + sdst) = R[4]; *(LAS u32x4*)(nb_ + 2 * P4_OPB + sdst + 64) = R[5]; } while (0)
    P4_LD2(0, rA); P4_ST2(0, rA); P4_LD2(1, rB);
    __syncthreads();
    a0 = (f32x16){}; a1 = (f32x16){}; m0 = (f32x16){}; m1 = (f32x16){};
#define P4_STEP2(kt, RL, RS) do { \
        const LAS char* buf = lds + ((kt) & 1) * P4_BUF2; \
        if ((kt) + 2 < nk) P4_LD2((kt) + 2, RL); \
        _Pragma("unroll") for (int s = 0; s < 4; ++s) { \
            const bf16x8 x = *(const LAS bf16x8*)(buf + xoff + s * 32); \
            const bf16x8 w0 = *(const LAS bf16x8*)(buf + woff + s * 32), w1 = *(const LAS bf16x8*)(buf + woff + 32 * P4_PITCH + s * 32); \
            const bf16x8 u0 = *(const LAS bf16x8*)(buf + P4_OPB + woff + s * 32), u1 = *(const LAS bf16x8*)(buf + P4_OPB + woff + 32 * P4_PITCH + s * 32); \
            a0 = __builtin_amdgcn_mfma_f32_32x32x16_bf16(w0, x, a0, 0, 0, 0); a1 = __builtin_amdgcn_mfma_f32_32x32x16_bf16(w1, x, a1, 0, 0, 0); \
            m0 = __builtin_amdgcn_mfma_f32_32x32x16_bf16(u0, x, m0, 0, 0, 0); m1 = __builtin_amdgcn_mfma_f32_32x32x16_bf16(u1, x, m1, 0, 0, 0); } \
        if ((kt) + 1 < nk) P4_ST2((((kt) + 1) & 1) * P4_BUF2, RS); \
        __syncthreads(); } while (0)
    for (int kt = 0; kt < nk; kt += 2) { P4_STEP2(kt, rA, rB); P4_STEP2(kt + 1, rB, rA); }
#undef P4_STEP2
#undef P4_LD2
#undef P4_ST2
}
__device__ __forceinline__ void p4_unit(int rt, int ct, const bf16_t* H, const bf16_t* YA, const bf16_t* YM, const bf16_t* Wga, const bf16_t* Wgm, const bf16_t* Wa, const bf16_t* Wb, bf16_t* MERGED, LAS char* lds) {
    int tid_ = threadIdx.x; asm volatile("" : "+v"(tid_)); const int tid = tid_, lane = tid & 63, r32 = lane & 31, hi = lane >> 5; const int wid = __builtin_amdgcn_readfirstlane(tid >> 6);
    const int wa = wid & 3, wb = wid >> 2;
    f32x16 g0, g1, m0, m1, c0, c1;
    p4_pass2(H, 1024, Wga, Wgm, rt, ct, g0, g1, m0, m1, lds, tid, r32, hi, wa, wb);
#pragma unroll
    for (int r = 0; r < 16; ++r) { g0[r] = sigm_f(g0[r]); g1[r] = sigm_f(g1[r]); m0[r] = sigm_f(m0[r]); m1[r] = sigm_f(m1[r]); }
    p4_pass(YA, 512, Wa, rt, ct, c0, c1, lds, tid, r32, hi, wa, wb);
    g0 *= c0; g1 *= c1;
    p4_pass(YM, 1024, Wb, rt, ct, c0, c1, lds, tid, r32, hi, wa, wb);
    g0 += m0 * c0; g1 += m1 * c1;
    bf16_t* op = MERGED + (size_t)(rt * 128 + wa * 32 + r32) * 1024 + ct * 128 + wb * 64 + 4 * hi;
#pragma unroll
    for (int g4 = 0; g4 < 4; ++g4) { u32x2 w; w.x = cvt_pk_bf16(g0[4 * g4], g0[4 * g4 + 1]); w.y = cvt_pk_bf16(g0[4 * g4 + 2], g0[4 * g4 + 3]); *(u32x2*)(op + 8 * g4) = w;
        u32x2 v; v.x = cvt_pk_bf16(g1[4 * g4], g1[4 * g4 + 1]); v.y = cvt_pk_bf16(g1[4 * g4 + 2], g1[4 * g4 + 3]); *(u32x2*)(op + 32 + 8 * g4) = v; }
}

__device__ __forceinline__ int crow(int r, int hi) { return (r & 3) + 8 * (r >> 2) + 4 * hi; }
__device__ __forceinline__ s16x4 vtr(const LAS char* p) { typedef short v4i16_t __attribute__((ext_vector_type(4))); return __builtin_bit_cast(s16x4, __builtin_amdgcn_ds_read_tr16_b64_v4i16((LAS v4i16_t*)p)); }
__device__ __forceinline__ bf16x8 cat8(s16x4 a, s16x4 b) { return (bf16x8){a[0], a[1], a[2], a[3], b[0], b[1], b[2], b[3]}; }
__device__ __forceinline__ bf16x8 packp(const f32x16& p, int b) { u32x4 w; w.x = cvt_pk_bf16(p[b], p[b + 1]); w.y = cvt_pk_bf16(p[b + 2], p[b + 3]); w.z = cvt_pk_bf16(p[b + 4], p[b + 5]); w.w = cvt_pk_bf16(p[b + 6], p[b + 7]); return __builtin_bit_cast(bf16x8, w); }
__device__ __forceinline__ float max3f(float a, float b, float c) { return fmaxf(fmaxf(a, b), c); }
__device__ __forceinline__ float max16(const f32x16& p) { float a = fmaxf(fmaxf(p[0], p[1]), fmaxf(p[2], p[3])), b = fmaxf(fmaxf(p[4], p[5]), fmaxf(p[6], p[7])), c = fmaxf(fmaxf(p[8], p[9]), fmaxf(p[10], p[11])), d = fmaxf(fmaxf(p[12], p[13]), fmaxf(p[14], p[15])); return fmaxf(fmaxf(a, b), fmaxf(c, d)); }

constexpr int KP = 208, VP = 192, KBUF = 64 * KP, VBUF = 64 * VP, STG = KBUF + VBUF;
__device__ __forceinline__ void mla_unit(int h, int qb, const bf16_t* __restrict__ Qm, const bf16_t* __restrict__ Km, const bf16_t* __restrict__ Kr, const bf16_t* __restrict__ Vm, bf16_t* ZM, LAS char* lds) {
    int tid_ = threadIdx.x; asm volatile("" : "+v"(tid_)); const int tid = tid_, lane = tid & 63, r32 = lane & 31, hi = lane >> 5; const int wid = __builtin_amdgcn_readfirstlane(tid >> 6);
    const int q0 = qb * 256, qrow = q0 + wid * 32 + r32;
    bf16x8 qf[6];
#pragma unroll
    for (int s = 0; s < 6; ++s) qf[s] = *(const bf16x8*)(Qm + (size_t)qrow * 1536 + h * 96 + 16 * s + 8 * hi);
    const int NT = (q0 + 256) / 64;
    const int srow = tid >> 3, sch = tid & 7, rrow = (tid & 255) >> 2, rch = tid & 3;
    const bf16_t* kn_src = Km + (size_t)srow * 1024 + h * 64 + sch * 8;
    const bf16_t* v_src = Vm + (size_t)srow * 1024 + h * 64 + sch * 8;
    const bf16_t* kr_src = Kr + (size_t)rrow * 32 + rch * 8;
    const int kn_dst = srow * KP + sch * 16, kr_dst = rrow * KP + 128 + rch * 16, v_dst = KBUF + srow * VP + sch * 16;
    u32x4 gknA, gkrA, gvA, gknB, gkrB, gvB;
    gknA = *(const u32x4*)kn_src; gvA = *(const u32x4*)v_src; gkrA = *(const u32x4*)kr_src;
    *(LAS u32x4*)(lds + kn_dst) = gknA; *(LAS u32x4*)(lds + v_dst) = gvA; if (tid < 256) *(LAS u32x4*)(lds + kr_dst) = gkrA;
    gknB = *(const u32x4*)(kn_src + (size_t)64 * 1024); gvB = *(const u32x4*)(v_src + (size_t)64 * 1024); gkrB = *(const u32x4*)(kr_src + (size_t)64 * 32);
    __syncthreads();
    float l = 0.f; f32x16 o0 = {}, o1 = {};
    const int ka_off = r32 * KP + hi * 16;
    const int i16 = lane & 15, dg = (lane >> 4) & 1;
    const int va_off = KBUF + (4 * hi + (i16 >> 2)) * VP + (16 * dg + 4 * (i16 & 3)) * 2;
    float mref = 0.f; f32x16 negm = {};
#define MLA_SB() __builtin_amdgcn_sched_barrier(0)
#define MLA_EX4(S, b) do { S[b] = fast_exp2(S[b]); S[b + 1] = fast_exp2(S[b + 1]); S[b + 2] = fast_exp2(S[b + 2]); S[b + 3] = fast_exp2(S[b + 3]); ps += (S[b] + S[b + 1]) + (S[b + 2] + S[b + 3]); } while (0)
#define MLA_STEP(t, GKN_LD, GV_LD, GKR_LD, GKN_ST, GV_ST, GKR_ST) do { \
        const LAS char* buf = lds + ((t) & 1) * STG; \
        { const size_t o = (size_t)((t) + 2 < NT ? (t) + 2 : NT - 1) * 64; GKN_LD = *(const u32x4*)(kn_src + o * 1024); GV_LD = *(const u32x4*)(v_src + o * 1024); GKR_LD = *(const u32x4*)(kr_src + o * 32); }     \
        const int jb = (t) - (NT - 4); \
        if (!(jb >= 0 && 2 * jb > wid)) { \
              \
            bf16x8 ka[6], kb[6]; \
            _Pragma("unroll") for (int s = 0; s < 6; ++s) ka[s] = *(const LAS bf16x8*)(buf + ka_off + s * 32); \
            MLA_SB(); \
            _Pragma("unroll") for (int s = 0; s < 6; ++s) kb[s] = *(const LAS bf16x8*)(buf + ka_off + 32 * KP + s * 32); \
            MLA_SB(); \
            f32x16 s0 = negm, s1 = negm; float ps = 0.f; \
            __builtin_amdgcn_s_setprio(1); \
              \
            s0 = __builtin_amdgcn_mfma_f32_32x32x16_bf16(ka[0], qf[0], s0, 0, 0, 0); s1 = __builtin_amdgcn_mfma_f32_32x32x16_bf16(kb[0], qf[0], s1, 0, 0, 0); \
            s0 = __builtin_amdgcn_mfma_f32_32x32x16_bf16(ka[1], qf[1], s0, 0, 0, 0); s1 = __builtin_amdgcn_mfma_f32_32x32x16_bf16(kb[1], qf[1], s1, 0, 0, 0); \
            MLA_SB(); \
            const LAS char* vp0 = buf + va_off; \
            s16x4 v0[8]; \
            _Pragma("unroll") for (int ks = 0; ks < 2; ++ks) { v0[4 * ks] = vtr(vp0 + ks * 16 * VP); v0[4 * ks + 1] = vtr(vp0 + ks * 16 * VP + 8 * VP); v0[4 * ks + 2] = vtr(vp0 + ks * 16 * VP + 64); v0[4 * ks + 3] = vtr(vp0 + ks * 16 * VP + 8 * VP + 64); } \
            _Pragma("unroll") for (int s = 2; s < 6; ++s) s0 = __builtin_amdgcn_mfma_f32_32x32x16_bf16(ka[s], qf[s], s0, 0, 0, 0); \
            MLA_SB(); \
            if (jb >= 0) { _Pragma("unroll") for (int r = 0; r < 16; ++r) { const int kv = 64 * (t) + crow(r, hi); if (kv > qrow) s0[r] = NEGB; } } \
            float ra = max3f(s0[0], s0[1], s0[2]); ra = max3f(ra, s0[3], s0[4]); ra = max3f(ra, s0[5], s0[6]); ra = max3f(ra, s0[7], s0[8]); ra = max3f(ra, s0[9], s0[10]); ra = max3f(ra, s0[11], s0[12]); ra = max3f(ra, s0[13], s0[14]); ra = fmaxf(ra, s0[15]); \
            s1 = __builtin_amdgcn_mfma_f32_32x32x16_bf16(kb[2], qf[2], s1, 0, 0, 0); MLA_EX4(s0, 0); MLA_SB(); \
            s1 = __builtin_amdgcn_mfma_f32_32x32x16_bf16(kb[3], qf[3], s1, 0, 0, 0); MLA_EX4(s0, 4); MLA_SB(); \
            bf16x8 pb0, pb1; \
            s1 = __builtin_amdgcn_mfma_f32_32x32x16_bf16(kb[4], qf[4], s1, 0, 0, 0); MLA_EX4(s0, 8); pb0 = packp(s0, 0); MLA_SB(); \
            s1 = __builtin_amdgcn_mfma_f32_32x32x16_bf16(kb[5], qf[5], s1, 0, 0, 0); MLA_EX4(s0, 12); MLA_SB(); \
            pb1 = packp(s0, 8); \
            __builtin_amdgcn_s_setprio(0); \
            s16x4 v1[8];                                                       \
            _Pragma("unroll") for (int ks = 0; ks < 2; ++ks) { v1[4 * ks] = vtr(vp0 + (ks + 2) * 16 * VP); v1[4 * ks + 1] = vtr(vp0 + (ks + 2) * 16 * VP + 8 * VP); v1[4 * ks + 2] = vtr(vp0 + (ks + 2) * 16 * VP + 64); v1[4 * ks + 3] = vtr(vp0 + (ks + 2) * 16 * VP + 8 * VP + 64); } \
            MLA_SB(); \
            if (jb >= 0) { _Pragma("unroll") for (int r = 0; r < 16; ++r) { const int kv = 64 * (t) + crow(r, hi); if (kv + 32 > qrow) s1[r] = NEGB; } } \
            float rb = max3f(s1[0], s1[1], s1[2]); rb = max3f(rb, s1[3], s1[4]); rb = max3f(rb, s1[5], s1[6]); rb = max3f(rb, s1[7], s1[8]); rb = max3f(rb, s1[9], s1[10]); rb = max3f(rb, s1[11], s1[12]); rb = max3f(rb, s1[13], s1[14]); rb = fmaxf(rb, s1[15]); \
            float rm = fmaxf(ra, rb); { const auto rr_ = __builtin_amdgcn_permlane32_swap(__float_as_uint(rm), __float_as_uint(rm), false, false); rm = fmaxf(__uint_as_float(rr_[0]), __uint_as_float(rr_[1])); }     \
            if ((t) == 0 || __any(rm > 8.0f)) { \
                const float dl = (t) == 0 ? rm : fmaxf(rm, 0.f); mref += dl; const float f = fast_exp2(-dl); \
                _Pragma("unroll") for (int r = 0; r < 16; ++r) { s0[r] *= f; s1[r] -= dl; negm[r] = -mref; } \
                ps *= f; l *= f; o0 *= f; o1 *= f; pb0 = packp(s0, 0); pb1 = packp(s0, 8); } \
            MLA_SB(); \
            __builtin_amdgcn_s_setprio(1); \
            o0 = __builtin_amdgcn_mfma_f32_32x32x16_bf16(cat8(v0[0], v0[1]), pb0, o0, 0, 0, 0); MLA_EX4(s1, 0); MLA_SB(); \
            o1 = __builtin_amdgcn_mfma_f32_32x32x16_bf16(cat8(v0[2], v0[3]), pb0, o1, 0, 0, 0); MLA_EX4(s1, 4); MLA_SB(); \
            bf16x8 pb2; \
            o0 = __builtin_amdgcn_mfma_f32_32x32x16_bf16(cat8(v0[4], v0[5]), pb1, o0, 0, 0, 0); MLA_EX4(s1, 8); pb2 = packp(s1, 0); MLA_SB(); \
            o1 = __builtin_amdgcn_mfma_f32_32x32x16_bf16(cat8(v0[6], v0[7]), pb1, o1, 0, 0, 0); MLA_EX4(s1, 12); MLA_SB(); \
            l += ps; \
            const bf16x8 pb3 = packp(s1, 8); \
            MLA_SB(); \
            o0 = __builtin_amdgcn_mfma_f32_32x32x16_bf16(cat8(v1[0], v1[1]), pb2, o0, 0, 0, 0); o1 = __builtin_amdgcn_mfma_f32_32x32x16_bf16(cat8(v1[2], v1[3]), pb2, o1, 0, 0, 0); \
            o0 = __builtin_amdgcn_mfma_f32_32x32x16_bf16(cat8(v1[4], v1[5]), pb3, o0, 0, 0, 0); o1 = __builtin_amdgcn_mfma_f32_32x32x16_bf16(cat8(v1[6], v1[7]), pb3, o1, 0, 0, 0); \
            __builtin_amdgcn_s_setprio(0); \
            MLA_SB(); \
        } \
        if ((t) + 1 < NT) { LAS char* nb = lds + (((t) + 1) & 1) * STG; *(LAS u32x4*)(nb + kn_dst) = GKN_ST; *(LAS u32x4*)(nb + v_dst) = GV_ST; if (tid < 256) *(LAS u32x4*)(nb + kr_dst) = GKR_ST; } \
        __syncthreads(); } while (0)
    for (int t = 0; t < NT; t += 2) {
        MLA_STEP(t, gknA, gvA, gkrA, gknB, gvB, gkrB);
        MLA_STEP(t + 1, gknB, gvB, gkrB, gknA, gvA, gkrA);
    }
#undef MLA_STEP
#undef MLA_EX4
#undef MLA_SB
    l += __shfl_xor(l, 32); const float rl = fast_rcp(l);
    bf16_t* zp = ZM + (size_t)qrow * 1024 + h * 64 + 4 * hi;
#pragma unroll
    for (int db = 0; db < 2; ++db)
#pragma unroll
        for (int g4 = 0; g4 < 4; ++g4) { bf16_t* p = zp + 32 * db + 8 * g4; const u32x2 z = *(const u32x2*)p; const f32x16& o = db ? o1 : o0;
            u32x2 w; w.x = cvt_pk_bf16(o[4 * g4] * rl * bflo(z.x), o[4 * g4 + 1] * rl * bfhi(z.x)); w.y = cvt_pk_bf16(o[4 * g4 + 2] * rl * bflo(z.y), o[4 * g4 + 3] * rl * bfhi(z.y));
            *(u32x2*)p = w; }
}

constexpr int DL_V = 0, DL_LSE = 8 * 32 * VP, DL_TAB = DL_LSE + 3 * 512 * 4;
__device__ __forceinline__ void dil_unit(int hs, int un, bf16_t* BIG, bf16_t* ZA, const float* __restrict__ BT, LAS char* lds) {
    int tid_ = threadIdx.x; asm volatile("" : "+v"(tid_)); const int tid = tid_, lane = tid & 63, r32 = lane & 31, hi = lane >> 5; const int wid = __builtin_amdgcn_readfirstlane(tid >> 6);
    const int T0 = un * 512;
    LAS float* lse_l = (LAS float*)(lds + DL_LSE); LAS float* tab = (LAS float*)(lds + DL_TAB);
    for (int i = tid; i < 576; i += 512) tab[i] = BT[((i / 192) * 8 + hs) * 192 + (i % 192)];
    __syncthreads();
    LAS char* vst = lds + DL_V + wid * 32 * VP;
    const int i16 = lane & 15, dg = (lane >> 4) & 1;
    const int va_off = (4 * hi + (i16 >> 2)) * VP + (16 * dg + 4 * (i16 & 3)) * 2;
    for (int k = 0; k < 6; ++k) {
        const int item = wid + 8 * k, g = item >> 4, b = item & 15, sh = 2 * g, L = SEQ >> sh;
        const int p = b >> (4 - sh), sub = b & ((16 >> sh) - 1), m0 = (T0 >> sh) + 32 * sub;
        const size_t rowbase = (size_t)p * L;
        bf16_t* Qg = BIG + (size_t)(0 * 3 + g) * GSZ; const bf16_t* Kg = BIG + (size_t)(1 * 3 + g) * GSZ; const bf16_t* Vg = BIG + (size_t)(2 * 3 + g) * GSZ;
        const size_t qrow = rowbase + m0 + r32;
        bf16x8 qf[4];
#pragma unroll
        for (int s = 0; s < 4; ++s) qf[s] = *(const bf16x8*)(Qg + qrow * 512 + hs * 64 + 16 * s + 8 * hi);
        float mrun = NEGB, l = 0.f; f32x16 o0 = {}, o1 = {};
        const LAS float* tg = tab + g * 192;
        for (int c = 0; c < 5; ++c) {
            const int ks0 = m0 - 128 + 32 * c; if (ks0 < 0) continue;
            const bf16_t* kp = Kg + (rowbase + ks0 + r32) * 512 + hs * 64 + 8 * hi;
            bf16x8 ka[4];
#pragma unroll
            for (int s = 0; s < 4; ++s) ka[s] = *(const bf16x8*)(kp + 16 * s);
            u32x4 vv[4];
#pragma unroll
            for (int i = 0; i < 4; ++i) vv[i] = *(const u32x4*)(Vg + (rowbase + ks0 + (lane >> 3) + 8 * i) * 512 + hs * 64 + (lane & 7) * 8);
            f32x16 sc = {};
#pragma unroll
            for (int s = 0; s < 4; ++s) sc = __builtin_amdgcn_mfma_f32_32x32x16_bf16(ka[s], qf[s], sc, 0, 0, 0);
#pragma unroll
            for (int r = 0; r < 16; ++r) sc[r] += tg[160 - 32 * c + r32 - crow(r, hi)];
            float rm = max16(sc); rm = fmaxf(rm, __shfl_xor(rm, 32));
            const float mn = fmaxf(mrun, rm), alpha = fast_exp2(mrun - mn); mrun = mn;
            float ps = 0.f;
#pragma unroll
            for (int r = 0; r < 16; ++r) { sc[r] = fast_exp2(sc[r] - mn); ps += sc[r]; }
            l = l * alpha + ps; o0 *= alpha; o1 *= alpha;
            const bf16x8 pb0 = packp(sc, 0), pb1 = packp(sc, 8);
#pragma unroll
            for (int i = 0; i < 4; ++i) *(LAS u32x4*)(vst + ((lane >> 3) + 8 * i) * VP + (lane & 7) * 16) = vv[i];
            asm volatile("s_waitcnt lgkmcnt(0)" ::: "memory");
#pragma unroll
            for (int ks = 0; ks < 2; ++ks) { const bf16x8 pb = ks == 0 ? pb0 : pb1;
                const LAS char* vp = vst + va_off + ks * 16 * VP;
                const bf16x8 a0 = cat8(vtr(vp), vtr(vp + 8 * VP)), a1 = cat8(vtr(vp + 64), vtr(vp + 8 * VP + 64));
                o0 = __builtin_amdgcn_mfma_f32_32x32x16_bf16(a0, pb, o0, 0, 0, 0); o1 = __builtin_amdgcn_mfma_f32_32x32x16_bf16(a1, pb, o1, 0, 0, 0); }
            asm volatile("s_waitcnt lgkmcnt(0)" ::: "memory");
        }
        l += __shfl_xor(l, 32); const float rl = fast_rcp(l);
        if (hi == 0) lse_l[g * 512 + ((m0 + r32) << sh) + p - T0] = mrun + __builtin_amdgcn_logf(l);
        bf16_t* op = Qg + qrow * 512 + hs * 64 + 4 * hi;
#pragma unroll
        for (int db = 0; db < 2; ++db)
#pragma unroll
            for (int g4 = 0; g4 < 4; ++g4) { const f32x16& o = db ? o1 : o0;
                u32x2 w; w.x = cvt_pk_bf16(o[4 * g4] * rl, o[4 * g4 + 1] * rl); w.y = cvt_pk_bf16(o[4 * g4 + 2] * rl, o[4 * g4 + 3] * rl);
                *(u32x2*)(op + 32 * db + 8 * g4) = w; }
    }
    __syncthreads();
#pragma unroll 2
    for (int k = 0; k < 8; ++k) {
        const int piece = tid + 512 * k, tl = piece >> 3, ch = piece & 7, t = T0 + tl;
        const float l0 = lse_l[tl], l1 = lse_l[512 + tl], l2 = lse_l[1024 + tl];
        const float mx = fmaxf(l0, fmaxf(l1, l2));
        float w0 = fast_exp2(l0 - mx), w1 = fast_exp2(l1 - mx), w2 = fast_exp2(l2 - mx); const float rs = fast_rcp(w0 + w1 + w2); w0 *= rs; w1 *= rs; w2 *= rs;
        const u32x4 a = *(const u32x4*)(BIG + (size_t)t * 512 + hs * 64 + ch * 8);
        const u32x4 bq = *(const u32x4*)(BIG + GSZ + ((size_t)(t & 3) * (SEQ >> 2) + (t >> 2)) * 512 + hs * 64 + ch * 8);
        const u32x4 cq = *(const u32x4*)(BIG + 2 * GSZ + ((size_t)(t & 15) * (SEQ >> 4) + (t >> 4)) * 512 + hs * 64 + ch * 8);
        bf16_t* zp = ZA + (size_t)t * 512 + hs * 64 + ch * 8; const u32x4 z = *(const u32x4*)zp;
        u32x4 w;
#define CMB(f) w.f = cvt_pk_bf16((w0 * bflo(a.f) + w1 * bflo(bq.f) + w2 * bflo(cq.f)) * bflo(z.f), (w0 * bfhi(a.f) + w1 * bfhi(bq.f) + w2 * bfhi(cq.f)) * bfhi(z.f))
        CMB(x); CMB(y); CMB(z); CMB(w);
#undef CMB
        *(u32x4*)zp = w;
    }
    __syncthreads();
}


#define XB_TMO      128
#define XB_XCNT(j)  (256  + 64 * (j))
#define XB_XSUB(j)  (1280 + 64 * (j))
#define XB_XGEN(j)  (2304 + 64 * (j))
#define XB_TOP      3328
#define XB_TOPGEN   3392
#define XCD_BAR_WORDS 3456
#define XB_SPIN_CAP (1u << 18)

__device__ __forceinline__ unsigned xb_ld(unsigned* p)              { return __hip_atomic_load(p, __ATOMIC_RELAXED, __HIP_MEMORY_SCOPE_AGENT); }
__device__ __forceinline__ unsigned xb_add(unsigned* p, unsigned v) { return __hip_atomic_fetch_add(p, v, __ATOMIC_RELAXED, __HIP_MEMORY_SCOPE_AGENT); }
__device__ __forceinline__ unsigned xb_xcc_id() { return (unsigned)__builtin_amdgcn_s_getreg((3 << 11) | 20) & 0xFu; }
#define XB_SPIN(cond, bar) do { unsigned _sp = 0; while (cond) { __builtin_amdgcn_s_sleep(1); \
    if ((++_sp & 255u) == 0u) { if (xb_ld(&(bar)[XB_TMO])) break; if (_sp > XB_SPIN_CAP) { atomicAdd(&(bar)[XB_TMO], 1u); break; } } } } while (0)

struct XcdBarrier {
    unsigned* bar; unsigned x;
    volatile LAS unsigned* st;
};

__device__ __forceinline__ XcdBarrier xcd_barrier_post(unsigned* bar, volatile LAS unsigned* st) {
    XcdBarrier b; b.bar = bar; b.x = xb_xcc_id(); b.st = st;
    if (threadIdx.x == 0) (void)xb_add(&bar[XB_XCNT(b.x)], 1u);
    return b;
}
__device__ __forceinline__ void xcd_barrier_complete(unsigned* bar, unsigned x, unsigned& nloc, unsigned& nx) {
    const unsigned G = gridDim.x * gridDim.y * gridDim.z;
    unsigned sum, cnt, mine, sp = 0u;
    for (;;) {
        sum = 0u; cnt = 0u; mine = 0u;
#pragma unroll
        for (unsigned j = 0; j < 16; ++j) { const unsigned c = xb_ld(&bar[XB_XCNT(j)]); sum += c; cnt += (c > 0u) ? 1u : 0u; mine = (j == x) ? c : mine; }
        if (sum == G) break;
        __builtin_amdgcn_s_sleep(1);
        if ((++sp & 255u) == 0u) { if (xb_ld(&bar[XB_TMO])) break; if (sp > XB_SPIN_CAP) { atomicAdd(&bar[XB_TMO], 1u); break; } }
    }
    nloc = mine > 0u ? mine : 1u; nx = cnt > 0u ? cnt : 1u;
}

__device__ __forceinline__ void xcd_barrier(const XcdBarrier& b) {
    asm volatile("s_waitcnt vmcnt(0)" ::: "memory");
    __syncthreads();
    if (threadIdx.x == 0) {
        unsigned* bar = b.bar;
        __builtin_amdgcn_s_waitcnt(0);
        unsigned nloc = b.st[0], nx = b.st[1];
        if (nloc == 0u) { xcd_barrier_complete(bar, b.x, nloc, nx); b.st[0] = nloc; b.st[1] = nx; }
        const unsigned old = xb_add(&bar[XB_XSUB(b.x)], 1u);
        const unsigned gen = old / nloc;
        if (old + 1u == (gen + 1u) * nloc) {
            __builtin_amdgcn_fence(__ATOMIC_RELEASE, "agent");
            asm volatile("s_waitcnt vmcnt(0)" ::: "memory");
            const unsigned og = xb_add(&bar[XB_TOP], 1u);
            const unsigned tg = og / nx;
            if (og + 1u == (tg + 1u) * nx) xb_add(&bar[XB_TOPGEN], 1u);
            else XB_SPIN(xb_ld(&bar[XB_TOPGEN]) == tg, bar);
            __builtin_amdgcn_fence(__ATOMIC_ACQUIRE, "agent");
            xb_add(&bar[XB_XGEN(b.x)], 1u);
            asm volatile("s_waitcnt vmcnt(0)" ::: "memory");
        } else {
            XB_SPIN(xb_ld(&bar[XB_XGEN(b.x)]) == gen, bar);
            __builtin_amdgcn_fence(__ATOMIC_ACQUIRE, "agent");
            asm volatile("s_waitcnt vmcnt(0)" ::: "memory");
        }
    }
    __syncthreads();
}

__device__ __forceinline__ float wave_sum(float v) {
#pragma unroll
    for (int o = 1; o < 64; o <<= 1) v += __shfl_xor(v, o);
    return v;
}
__device__ __forceinline__ int rope_pos(int i) { return i < 16 ? 8 * (i >> 2) + (i & 3) : 8 * ((i - 16) >> 2) + 4 + (i & 3); }
__device__ __forceinline__ int dst_row(int mode, int n) {
    if (mode == 1) { if (n < 5504) return n; if (n < 5536) return 5504 + rope_pos(n - 5504); if (n < 6560) return 5632 + (n - 5536); return 6656 + (n - 6560); }
    if (mode == 2) { const int hd = n / 96, e = n - hd * 96; return e < 64 ? hd * 64 + e : 1024 + hd * 32 + rope_pos(e - 64); }
    if (mode == 3) { const int hd = n >> 7, e = n & 127; return e < 64 ? hd * 64 + e : 1024 + hd * 64 + (e - 64); }
    return n;
}
__device__ __forceinline__ void transpose_item(const float* __restrict__ W, int K, int N, bf16_t* WT, int mode, const float* __restrict__ kscale, LAS float* scr, int item, int lane) {
    const int nblk = N / 32, kb = item / nblk, nb = item % nblk, k0 = 64 * kb, n0 = 32 * nb;
#pragma unroll 8
    for (int i = 0; i < 32; ++i) { const int kk = 2 * i + (lane >> 5); float v = W[(size_t)(k0 + kk) * N + n0 + (lane & 31)]; if (kscale) v *= kscale[k0 + kk]; scr[kk * 33 + (lane & 31)] = v; }
    asm volatile("s_waitcnt lgkmcnt(0)" ::: "memory");
    const int c = lane & 7;
#pragma unroll
    for (int j = 0; j < 4; ++j) { const int n = (lane >> 3) + 8 * j; const LAS float* s = scr + (8 * c) * 33 + n;
        u32x4 o; o.x = cvt_pk_bf16(s[0 * 33], s[1 * 33]); o.y = cvt_pk_bf16(s[2 * 33], s[3 * 33]); o.z = cvt_pk_bf16(s[4 * 33], s[5 * 33]); o.w = cvt_pk_bf16(s[6 * 33], s[7 * 33]);
        *(u32x4*)(WT + (size_t)dst_row(mode, n0 + n) * K + k0 + 8 * c) = o; }
    asm volatile("s_waitcnt lgkmcnt(0)" ::: "memory");
}

struct Args { const float* in[16]; float* out; unsigned char* ws; int ph_lo, ph_hi; };
typedef const __attribute__((address_space(4))) Args* KArgs;

__device__ __forceinline__ void convert_weights(KArgs a, int layer, unsigned char* ws, LAS unsigned char* lds, int gw, int NGW, int wave, int lane) {
    LAS float* scr = (LAS float*)(lds + wave * 16384);
    const float* w_in = a->in[6] + (size_t)layer * DM * DIN; const float* w_uq = a->in[8] + (size_t)layer * 256 * 1536; const float* w_ukv = a->in[10] + (size_t)layer * 128 * 2048;
    const float* w_a = a->in[11] + (size_t)layer * 512 * 1024; const float* w_b = a->in[12] + (size_t)layer * 1024 * 1024; const float* w_o = a->in[13] + (size_t)layer * 1024 * 1024;
    const float* qg = a->in[7] + layer * 256; const float* kvg = a->in[9] + layer * 128;
    constexpr int I_IN = 16 * 269, I_UQ = 4 * 48, I_UKV = 2 * 64, I_A = 8 * 32, I_B = 16 * 32, I_O = 16 * 32, NIT = I_IN + I_UQ + I_UKV + I_A + I_B + I_O;
    for (int it = gw; it < NIT; it += NGW) {
        int r = it;
        if (r < I_IN) { transpose_item(w_in, 1024, DIN, (bf16_t*)(ws + WS_WIN), 1, nullptr, scr, r, lane); continue; } r -= I_IN;
        if (r < I_UQ) { transpose_item(w_uq, 256, 1536, (bf16_t*)(ws + WS_WUQ), 2, qg, scr, r, lane); continue; } r -= I_UQ;
        if (r < I_UKV) { transpose_item(w_ukv, 128, 2048, (bf16_t*)(ws + WS_WUKV), 3, kvg, scr, r, lane); continue; } r -= I_UKV;
        if (r < I_A) { transpose_item(w_a, 512, 1024, (bf16_t*)(ws + WS_WA), 0, nullptr, scr, r, lane); continue; } r -= I_A;
        if (r < I_B) { transpose_item(w_b, 1024, 1024, (bf16_t*)(ws + WS_WB), 0, nullptr, scr, r, lane); continue; } r -= I_B;
        transpose_item(w_o, 1024, 1024, (bf16_t*)(ws + WS_WO), 0, nullptr, scr, r, lane);
    }
}
__device__ __forceinline__ void adaln_rows(const float* x, const float* g, const float* mod, bf16_t* H, int gw, int NGW, int lane) {
    for (int m = gw; m < SEQ; m += NGW) {
        const f32x4* xr = (const f32x4*)(x + (size_t)m * DM) + lane; f32x4 v[4]; float s = 0.f;
#pragma unroll
        for (int j = 0; j < 4; ++j) { v[j] = xr[64 * j]; s += (v[j][0] * v[j][0] + v[j][1] * v[j][1]) + (v[j][2] * v[j][2] + v[j][3] * v[j][3]); }
        const float rstd = __builtin_amdgcn_rsqf(wave_sum(s) * (1.f / DM) + EPS);
        u32x2* o8 = (u32x2*)(H + (size_t)m * DM) + lane;
#pragma unroll
        for (int j = 0; j < 4; ++j) { const int c = 256 * j + 4 * lane; const f32x4 gg = *(const f32x4*)(g + c), sh = *(const f32x4*)(mod + c), sc = *(const f32x4*)(mod + 1024 + c);
            const f32x4 y = v[j] * rstd * gg * (sc + 1.f) + sh; u32x2 w; w.x = cvt_pk_bf16(y[0], y[1]); w.y = cvt_pk_bf16(y[2], y[3]); o8[64 * j] = w; }
    }
}
__device__ __forceinline__ void final_rows(float* x, const float* g, int gw, int NGW, int lane) {
    for (int m = gw; m < SEQ; m += NGW) {
        f32x4* xr = (f32x4*)(x + (size_t)m * DM) + lane; f32x4 v[4]; float s = 0.f;
#pragma unroll
        for (int j = 0; j < 4; ++j) { v[j] = xr[64 * j]; s += (v[j][0] * v[j][0] + v[j][1] * v[j][1]) + (v[j][2] * v[j][2] + v[j][3] * v[j][3]); }
        const float rstd = __builtin_amdgcn_rsqf(wave_sum(s) * (1.f / DM) + EPS);
#pragma unroll
        for (int j = 0; j < 4; ++j) { const f32x4 gg = *(const f32x4*)(g + 256 * j + 4 * lane); xr[64 * j] = v[j] * rstd * gg; }
    }
}

#define KARGS(name) KArgs name = (KArgs)__builtin_amdgcn_kernarg_segment_ptr(); asm volatile("" : "+s"(name))
#define GRID_SYNC() do { KARGS(kb_); XcdBarrier b_; b_.bar = (unsigned*)(kb_->ws + WS_BAR); b_.x = xb_xcc_id(); b_.st = (volatile LAS unsigned*)(lds + LDS_ST); xcd_barrier(b_); } while (0)
struct Ids { int G, bx, vcu; };
__device__ __forceinline__ Ids get_ids() { Ids r; r.G = gridDim.x; r.bx = blockIdx.x; r.vcu = (r.G % 8 == 0) ? (r.bx % 8) * (r.G / 8) + r.bx / 8 : r.bx; return r; }
#define FRESH_TID() int tid_ = threadIdx.x; asm volatile("" : "+v"(tid_)); const int tid = tid_, lane = tid & 63; const int wave = __builtin_amdgcn_readfirstlane(tid >> 6); (void)lane; (void)wave

__global__ void __launch_bounds__(NWAVES * 64, 2) fwd_mega(Args a_unused) {
    extern __shared__ __attribute__((aligned(16))) unsigned char lds_raw[];
    LAS unsigned char* lds = (LAS unsigned char*)lds_raw;
    int ph_lo, ph_hi; { KARGS(kp); ph_lo = kp->ph_lo; ph_hi = kp->ph_hi; }
    if (ph_lo < 0) cg::this_grid().sync();
    { KARGS(kb0); if (threadIdx.x < 2) ((LAS unsigned*)(lds + LDS_ST))[threadIdx.x] = 0u; __syncthreads(); (void)xcd_barrier_post((unsigned*)(kb0->ws + WS_BAR), (volatile LAS unsigned*)(lds + LDS_ST)); }
#define IN(k) (ph_lo <= (k) && (k) < ph_hi)
#define SEAM(k) do { if (IN(k) && IN((k) + 1)) GRID_SYNC(); } while (0)

    if (IN(0)) {
        KARGS(ka); FRESH_TID(); const Ids id = get_ids(); const int G = id.G, bx = id.bx;
        unsigned char* ws = ka->ws; const float* cvec = ka->in[1]; const int* pos = (const int*)ka->in[2]; const float* w_ada = ka->in[3]; const float* b_ada = ka->in[4]; const float* rel_bias = ka->in[14];
        float* MOD = (float*)(ws + WS_MOD); float* BT = (float*)(ws + WS_BT); float* COS = (float*)(ws + WS_COS); float* SIN = (float*)(ws + WS_SIN);
        LAS float* red = (LAS float*)(lds + 8 * 16384);
        for (int it = bx; it < 192; it += G) {
            const int l = it / 96, n0 = (it % 96) * 32, col = lane & 31, kh = lane >> 5; const float* wp = w_ada + (size_t)l * DM * 3072 + n0 + col; float s = 0.f;
            const int kbeg = wave * 128 + kh * 64;
#pragma unroll 16
            for (int k = 0; k < 64; ++k) { const float cv = cvec[kbeg + k]; s += silu_f(cv) * wp[(size_t)(kbeg + k) * 3072]; }
            red[wave * 64 + lane] = s; __syncthreads();
            if (tid < 32) { float t = b_ada[l * 3072 + n0 + tid]; for (int i = 0; i < 16; ++i) t += red[i * 32 + tid]; MOD[l * 3072 + n0 + tid] = t; }
            __syncthreads();
        }
        const int gt = id.vcu * 512 + tid, NGT = G * 512;
        for (int i = gt; i < 24 * 192; i += NGT) { const int gh = i / 192, idx = i % 192, g = gh >> 3, j = idx - 32; float v = NEGB;
            if (j >= 0 && j <= 128) { const int dist = j << (2 * g); int bucket;
                if (dist < 16) bucket = dist; else { bucket = 16 + (int)(logf((float)dist / 16.f) / 4.852030263919617f * 16.f); bucket = bucket < 31 ? bucket : 31; }
                v = rel_bias[bucket * 24 + gh] * LOG2E; }
            BT[i] = v; }
        for (int i = gt; i < SEQ * 16; i += NGT) { const int t = i >> 4, f = i & 15; const float inv = 1.0f / exp2f((float)f * (13.287712379549449f / 16.f));
            const float ang = (float)pos[t] * inv; double rev = (double)ang * 0.15915494309189535; rev -= floor(rev);
            COS[i] = __builtin_amdgcn_cosf((float)rev); SIN[i] = __builtin_amdgcn_sinf((float)rev); }
        convert_weights(ka, 0, ws, lds, id.vcu * NWAVES + wave, G * NWAVES, wave, lane);
    }
    SEAM(0);
#pragma unroll
    for (int layer = 0; layer < 2; ++layer) {
        const int pb = 1 + 7 * layer;
        if (IN(pb)) {
            KARGS(ka); FRESH_TID(); const Ids id = get_ids(); unsigned char* ws = ka->ws;
            if (layer == 1) convert_weights(ka, 1, ws, lds, id.vcu * NWAVES + wave, id.G * NWAVES, wave, lane);
            adaln_rows(layer == 0 ? ka->in[0] : (const float*)ka->out, ka->in[5] + layer * DM, (const float*)(ws + WS_MOD) + layer * 3072, (bf16_t*)(ws + WS_H), id.vcu * NWAVES + wave, id.G * NWAVES, lane);
        }
        SEAM(pb + 0);
#if PH&1
        if (IN(pb + 1))
        { KARGS(ka); const Ids id = get_ids(); unsigned char* ws = ka->ws;
          pg8::Gemm g{(const bf16_t*)(ws + WS_H), (const bf16_t*)(ws + WS_WIN), SEQ, 6656, 1024}; pg8::StaticOrder S; S.init(SEQ, 6656, id.G, id.bx);
          EpiIn E{(bf16_t*)(ws + WS_BIG), (bf16_t*)(ws + WS_ZA), (bf16_t*)(ws + WS_ZM), (bf16_t*)(ws + WS_CQ), (bf16_t*)(ws + WS_CKV), (bf16_t*)(ws + WS_KR), (float*)(ws + WS_SSQ), (float*)(ws + WS_SSKV), (const float*)(ws + WS_COS), (const float*)(ws + WS_SIN)};
          GEMM_PHASE(EpiIn, lds, g, S, E); }
#endif
        SEAM(pb + 1);
#if PH&2
        if (IN(pb + 2))
        { KARGS(ka); const Ids id = get_ids(); unsigned char* ws = ka->ws;
          for (int un = id.vcu; un < 256; un += id.G) dil_unit(un >> 5, un & 31, (bf16_t*)(ws + WS_BIG), (bf16_t*)(ws + WS_ZA), (const float*)(ws + WS_BT), (LAS char*)lds);
        }
#endif
        SEAM(pb + 2);
#if PH&4
        if (IN(pb + 3))
        { KARGS(ka); const Ids id = get_ids(); unsigned char* ws = ka->ws; bf16_t* Qm = (bf16_t*)(ws + WS_BIG);
          { pg8::Gemm g{(const bf16_t*)(ws + WS_CQ), (const bf16_t*)(ws + WS_WUQ), SEQ, 1536, 256}; pg8::StaticOrder S; S.init(SEQ, 1536, id.G, id.bx); EpiUq E{Qm, (const float*)(ws + WS_SSQ), (const float*)(ws + WS_COS), (const float*)(ws + WS_SIN)};
            GEMM_PHASE(EpiUq, lds, g, S, E); }
          { pg8::Gemm g{(const bf16_t*)(ws + WS_CKV), (const bf16_t*)(ws + WS_WUKV), SEQ, 2048, 128}; pg8::StaticOrder S; S.init(SEQ, 2048, id.G, id.bx); EpiUkv E{Qm + (size_t)SEQ * 1536, Qm + (size_t)SEQ * 2560, (const float*)(ws + WS_SSKV)};
            GEMM_PHASE(EpiUkv, lds, g, S, E); } }
#endif
        SEAM(pb + 3);
#if PH&8
        if (IN(pb + 4))
        { KARGS(ka); const Ids id = get_ids(); unsigned char* ws = ka->ws; const bf16_t* Qm = (const bf16_t*)(ws + WS_BIG);
          for (int i = 0; i < 4; ++i)
            for (int v = id.vcu; v < 256; v += id.G) { const int s = v & 15, hd = v >> 4; const int qb = i == 0 ? 63 - s : i == 1 ? 32 + s : i == 2 ? 31 - s : s;
                mla_unit(hd, qb, Qm, Qm + (size_t)SEQ * 1536, (const bf16_t*)(ws + WS_KR), Qm + (size_t)SEQ * 2560, (bf16_t*)(ws + WS_ZM), (LAS char*)lds); }
        }
#endif
        SEAM(pb + 4);
#if PH&16
        if (IN(pb + 5))
        { KARGS(ka); const Ids id = get_ids(); unsigned char* ws = ka->ws; bf16_t* MERGED = (bf16_t*)(ws + WS_BIG);
          const bf16_t* H = (const bf16_t*)(ws + WS_H); const bf16_t* WIN = (const bf16_t*)(ws + WS_WIN);
          for (int un = id.vcu; un < 1024; un += id.G) p4_unit(un >> 3, un & 7, H, (const bf16_t*)(ws + WS_ZA), (const bf16_t*)(ws + WS_ZM), WIN + (size_t)6656 * 1024, WIN + (size_t)7680 * 1024, (const bf16_t*)(ws + WS_WA), (const bf16_t*)(ws + WS_WB), MERGED, (LAS char*)lds); }
#endif
        SEAM(pb + 5);
#if PH&32
        if (IN(pb + 6))
        { KARGS(ka); const Ids id = get_ids(); unsigned char* ws = ka->ws;
          pg8::Gemm g{(const bf16_t*)(ws + WS_BIG), (const bf16_t*)(ws + WS_WO), SEQ, 1024, 1024}; pg8::StaticOrder S; S.init(SEQ, 1024, id.G, id.bx);
          EpiRes E{layer == 0 ? ka->in[0] : (const float*)ka->out, ka->out, (const float*)(ws + WS_MOD) + layer * 3072 + 2048};
          GEMM_PHASE(EpiRes, lds, g, S, E); }
#endif
        SEAM(pb + 6);
    }
    if (IN(15)) { KARGS(ka); FRESH_TID(); const Ids id = get_ids(); final_rows(ka->out, ka->in[15], id.vcu * NWAVES + wave, id.G * NWAVES, lane); }
}


extern "C" void kernel_launch(void* const* d_in, const int* in_sizes, int n_in, void* d_out, int out_size, void* d_ws, size_t ws_size, hipStream_t stream) {
    static int grid = 0;
    if (grid == 0) {
        if (n_in != 16 || out_size != SEQ * DM || ws_size < WS_END) { fprintf(stderr, "kernel_launch: unexpected problem: n_in %d out %d ws %zu (need %zu)\n", n_in, out_size, ws_size, (size_t)WS_END); grid = -1; return; }
        int dev = 0, cus = 0, per_cu = 0;
        if (hipGetDevice(&dev) != hipSuccess || hipDeviceGetAttribute(&cus, hipDeviceAttributeMultiprocessorCount, dev) != hipSuccess) { grid = -1; return; }
        if (hipFuncSetAttribute((const void*)fwd_mega, hipFuncAttributeMaxDynamicSharedMemorySize, LDS_BYTES) != hipSuccess) { fprintf(stderr, "kernel_launch: hipFuncSetAttribute failed\n"); grid = -1; return; }
        if (hipOccupancyMaxActiveBlocksPerMultiprocessor(&per_cu, (const void*)fwd_mega, NWAVES * 64, LDS_BYTES) != hipSuccess || per_cu < 1) fprintf(stderr, "kernel_launch: occupancy query says %d\n", per_cu);
        (void)hipGetLastError();
        grid = cus;
    }
    if (grid < 0) return;
    if (hipMemsetAsync((char*)d_ws + WS_BAR, 0, 16384, stream) != hipSuccess) { fprintf(stderr, "kernel_launch: memset failed\n"); return; }
    Args a{};
    for (int i = 0; i < 16; ++i) a.in[i] = (const float*)d_in[i];
    a.out = (float*)d_out; a.ws = (unsigned char*)d_ws;
#if N_LAUNCH == 1
    a.ph_lo = 0; a.ph_hi = 16;
    void* args[] = {&a};
    hipError_t e = hipLaunchCooperativeKernel((const void*)fwd_mega, dim3(grid), dim3(NWAVES * 64), args, LDS_BYTES, stream);
    if (e != hipSuccess) fprintf(stderr, "kernel_launch: cooperative launch failed: %s (grid %d)\n", hipGetErrorString(e), grid);
#else
    for (int p = 0; p < 16; ++p) { a.ph_lo = p; a.ph_hi = p + 1; hipLaunchKernelGGL(fwd_mega, dim3(grid), dim3(NWAVES * 64), LDS_BYTES, stream, a); }
#endif
}
```

```cpp
#include <hip/hip_runtime.h>
#include <hip/hip_cooperative_groups.h>
#include <cstdio>
#include <cstdint>
namespace cg = cooperative_groups;
#ifndef N_LAUNCH
#define N_LAUNCH 1
#endif
#ifndef PH
#define PH 63
#endif
namespace pg8 {
#define PG8_LAS __attribute__((address_space(3)))
typedef unsigned short bf16_t;
typedef short bf16x8 __attribute__((ext_vector_type(8)));
typedef float f32x4 __attribute__((ext_vector_type(4)));
typedef unsigned u32x4 __attribute__((ext_vector_type(4)));
constexpr int BM = 256, BK = 64, HALF = 128, HTB = HALF * BK * 2  , STAGE_BYTES = 8 * HTB, NXCD = 8, WGM = 8;

__host__ __device__ __forceinline__ int lds_byte(int r, int c) { const int st = (r >> 4) * 2 + (c >> 5), rr = r & 15, cc = c & 31, ob = rr * 64 + cc * 2; return st * 1024 + (ob ^ (((ob >> 9) & 1) << 5)); }
__host__ __device__ __forceinline__ void stage_rc(int b, int& R, int& C) { const int st = b / 1024, sb = b % 1024, swz = sb ^ (((sb >> 9) & 1) << 5); R = (st >> 1) * 16 + swz / 64; C = (st & 1) * 32 + (swz % 64) / 2; }
__host__ __device__ __forceinline__ int perm32(int rho) { const int n = rho >> 4, i = rho & 15; return 8 * (i >> 2) + 4 * n + (i & 3); }

struct Unit { int pm, pn; };
struct Gemm { const bf16_t* A; const bf16_t* Bt; int M, N, K; };

struct StaticOrder {
    int nM, nN, nwg, G, c;
    __host__ __device__ void init(int M, int N, int G_, int c_) { nM = M / BM; nN = N / BM; nwg = nM * nN; G = G_; c = c_; }
    __host__ __device__ bool next(int i, Unit& u) const {
        const long L = (long)i * G + c; if (L >= nwg) return false;
        int wgid = (int)L; { const int q = nwg / NXCD, r = nwg % NXCD, xcd = wgid % NXCD, off = wgid / NXCD; wgid = (xcd < r ? xcd * (q + 1) : r * (q + 1) + (xcd - r) * q) + off; }
        const int nig = WGM * nN, gid = wgid / nig, fm = gid * WGM, gsz = (nM - fm) < WGM ? (nM - fm) : WGM;
        u.pm = fm + ((wgid % nig) % gsz); u.pn = (wgid % nig) / gsz; return true;
    }
    __device__ __forceinline__ void a_ready(const Unit&) const {}
    __device__ __forceinline__ void done(const Unit&) const {}
};

__device__ __forceinline__ unsigned cvt_pk_bf16(float lo, float hi) { unsigned r; asm volatile("v_cvt_pk_bf16_f32 %0, %1, %2" : "=v"(r) : "v"(lo), "v"(hi)); return r; }
template <class Epi, class Sched, bool ALIGN_EPI = false, bool SP2 = false>
__device__ __forceinline__ void gemm_phase(PG8_LAS unsigned char* lds, const Gemm g, const Sched& S, const Epi& E) {
    int tid_ = threadIdx.x; asm volatile("" : "+v"(tid_));
    const int tid = tid_, wid = __builtin_amdgcn_readfirstlane(tid >> 6), lane = tid & 63, wr = wid >> 2, wc = wid & 3, fr = lane & 15, fq = lane >> 4;
    int K_ = g.K; asm volatile("" : "+s"(K_)); const int K = K_, nt = K / BK;
    unsigned voffA[2], voffB[2];
#pragma unroll
    for (int i = 0; i < 2; ++i) { int R, C; stage_rc(tid * 16 + i * 8192, R, C); const int Rb = Epi::PERM ? ((R & ~31) + perm32(R & 31)) : R;
        voffA[i] = (unsigned)(R * K + C) * 2u; voffB[i] = (unsigned)(Rb * K + C) * 2u; }
    const size_t kstep = (size_t)(BK * 2);
    const size_t hstep = (size_t)HALF * K * 2;
    const size_t tstep = 2 * hstep;
    const unsigned ldsw = (unsigned)wid * 1024u;
    const int aoff = lds_byte(wr * 64 + fr, fq * 8), boff = lds_byte(wc * 32 + fr, fq * 8);
#define PG8_SA(b, h) (((b) * 2 + (h)) * HTB)
#define PG8_SB(b, h) ((4 + (b) * 2 + (h)) * HTB)
#define PG8_STAGE(bufoff, gbase, voff) do { _Pragma("unroll") for (int _i = 0; _i < 2; ++_i) \
        __builtin_amdgcn_global_load_lds((const unsigned*)((const char*)(gbase) + (voff)[_i]), (PG8_LAS unsigned*)(lds + (bufoff) + ldsw + _i * 8192), 16, 0, 0); } while (0)
#define PG8_LDA(dst, b, h) do { _Pragma("unroll") for (int m = 0; m < 4; ++m) _Pragma("unroll") for (int k = 0; k < 2; ++k) dst[m][k] = *(const PG8_LAS bf16x8*)(lds + PG8_SA(b, h) + aoff + m * 2048 + k * 1024); } while (0)
#define PG8_LDB(dst, b, h) do { _Pragma("unroll") for (int n = 0; n < 2; ++n) _Pragma("unroll") for (int k = 0; k < 2; ++k) dst[n][k] = *(const PG8_LAS bf16x8*)(lds + PG8_SB(b, h) + boff + n * 2048 + k * 1024); } while (0)
#define PG8_MMA(ai, bj, At, Bt) do { __builtin_amdgcn_s_setprio(1); _Pragma("unroll") for (int m = 0; m < 4; ++m) _Pragma("unroll") for (int n = 0; n < 2; ++n) _Pragma("unroll") for (int k = 0; k < 2; ++k) \
        acc[ai][bj][m][n] = __builtin_amdgcn_mfma_f32_16x16x32_bf16(Bt[n][k], At[m][k], acc[ai][bj][m][n], 0, 0, 0); __builtin_amdgcn_s_setprio(0); } while (0)
#define PG8_WAIT_V(n) asm volatile("s_waitcnt vmcnt(" #n ")" ::: "memory")
#define PG8_WAIT_L(n) asm volatile("s_waitcnt lgkmcnt(" #n ")" ::: "memory")
#define PG8_BAR __builtin_amdgcn_s_barrier()
#define PG8_SCHED __builtin_amdgcn_sched_barrier(0)
    Unit cur, nxt; int ui = 0;
    if (!S.next(0, cur)) return;
    f32x4 acc[2][2][4][2];
#pragma unroll
    for (int a = 0; a < 2; ++a)
#pragma unroll
        for (int b = 0; b < 2; ++b)
#pragma unroll
            for (int m = 0; m < 4; ++m)
#pragma unroll
                for (int n = 0; n < 2; ++n) acc[a][b][m][n] = (f32x4){0.f, 0.f, 0.f, 0.f};
    bf16x8 At[4][2], B0[2][2], B1[2][2];
    const char* cA = (const char*)g.A + (size_t)cur.pm * tstep; const char* cB = (const char*)g.Bt + (size_t)cur.pn * tstep;
    S.a_ready(cur);
    if constexpr (SP2) {
        PG8_STAGE(PG8_SB(0, 0), cB, voffB); PG8_STAGE(PG8_SB(0, 1), cB + hstep, voffB); PG8_STAGE(PG8_SA(0, 0), cA, voffA); PG8_STAGE(PG8_SA(0, 1), cA + hstep, voffA);
        if (wr == 1) PG8_BAR;
        PG8_WAIT_V(2); PG8_BAR;
        PG8_STAGE(PG8_SB(1, 0), cB + kstep, voffB); PG8_STAGE(PG8_SA(1, 0), cA + kstep, voffA); PG8_STAGE(PG8_SB(1, 1), cB + hstep + kstep, voffB);
        PG8_WAIT_V(6); PG8_BAR;
    } else {
        PG8_STAGE(PG8_SB(0, 0), cB, voffB); PG8_STAGE(PG8_SA(0, 0), cA, voffA); PG8_STAGE(PG8_SB(0, 1), cB + hstep, voffB); PG8_STAGE(PG8_SA(0, 1), cA + hstep, voffA);
        if (wr == 1) PG8_BAR;
        PG8_WAIT_V(4); PG8_BAR;
        PG8_STAGE(PG8_SB(1, 0), cB + kstep, voffB); PG8_STAGE(PG8_SA(1, 0), cA + kstep, voffA); PG8_STAGE(PG8_SB(1, 1), cB + hstep + kstep, voffB);
        PG8_WAIT_V(6); PG8_BAR;
    }
    for (;;) {
        const bool has_next = S.next(ui + 1, nxt);
        const char* nA = has_next ? (const char*)g.A + (size_t)nxt.pm * tstep : cA; const char* nB = has_next ? (const char*)g.Bt + (size_t)nxt.pn * tstep : cB;
        for (int t = 0; t < nt; t += 2) {
            const bool last = (t == nt - 2);
            const char* a1 = cA + (size_t)(t + 1) * kstep;
            const char* a2 = last ? nA : cA + (size_t)(t + 2) * kstep; const char* b2 = last ? nB : cB + (size_t)(t + 2) * kstep;
            const char* a3 = a2 + kstep; const char* b3 = b2 + kstep;
            if (last && has_next) S.a_ready(nxt);
            if constexpr (SP2) {
            PG8_LDB(B0, 0, 0); PG8_LDB(B1, 0, 1); PG8_SCHED; PG8_LDA(At, 0, 0); PG8_STAGE(PG8_SA(1, 1), a1 + hstep, voffA);
            PG8_WAIT_V(8); PG8_WAIT_L(0); PG8_BAR; PG8_MMA(0, 0, At, B0); PG8_MMA(0, 1, At, B1); PG8_BAR; PG8_SCHED;
            PG8_LDA(At, 0, 1); PG8_STAGE(PG8_SB(0, 0), b2, voffB); PG8_STAGE(PG8_SB(0, 1), b2 + hstep, voffB); PG8_STAGE(PG8_SA(0, 0), a2, voffA);
            PG8_WAIT_V(8); PG8_WAIT_L(0); PG8_BAR; PG8_MMA(1, 0, At, B0); PG8_MMA(1, 1, At, B1); PG8_BAR; PG8_SCHED;
            PG8_LDB(B0, 1, 0); PG8_LDB(B1, 1, 1); PG8_SCHED; PG8_LDA(At, 1, 0); PG8_STAGE(PG8_SA(0, 1), a2 + hstep, voffA);
            PG8_WAIT_V(8); PG8_WAIT_L(0); PG8_BAR; PG8_MMA(0, 0, At, B0); PG8_MMA(0, 1, At, B1); PG8_BAR; PG8_SCHED;
            PG8_LDA(At, 1, 1); PG8_STAGE(PG8_SB(1, 0), b3, voffB); PG8_STAGE(PG8_SB(1, 1), b3 + hstep, voffB); PG8_STAGE(PG8_SA(1, 0), a3, voffA);
            PG8_WAIT_V(8); PG8_WAIT_L(0); PG8_BAR; PG8_MMA(1, 0, At, B0); PG8_MMA(1, 1, At, B1); PG8_BAR; PG8_SCHED;
            } else {
            PG8_LDB(B0, 0, 0); PG8_SCHED; PG8_LDA(At, 0, 0); PG8_STAGE(PG8_SA(1, 1), a1 + hstep, voffA);
            PG8_WAIT_L(8); PG8_BAR; PG8_WAIT_L(0); PG8_MMA(0, 0, At, B0); PG8_BAR; PG8_SCHED;
            PG8_LDB(B1, 0, 1); PG8_STAGE(PG8_SB(0, 0), b2, voffB);
            PG8_BAR; PG8_WAIT_L(0); PG8_MMA(0, 1, At, B1); PG8_BAR;
            PG8_LDA(At, 0, 1); PG8_STAGE(PG8_SA(0, 0), a2, voffA);
            PG8_BAR; PG8_WAIT_L(0); PG8_MMA(1, 0, At, B0); PG8_BAR; PG8_SCHED;
            PG8_STAGE(PG8_SB(0, 1), b2 + hstep, voffB);
            PG8_WAIT_V(6); PG8_BAR; PG8_MMA(1, 1, At, B1); PG8_BAR;
            PG8_LDB(B0, 1, 0); PG8_SCHED; PG8_LDA(At, 1, 0); PG8_STAGE(PG8_SA(0, 1), a2 + hstep, voffA);
            PG8_WAIT_L(8); PG8_BAR; PG8_WAIT_L(0); PG8_MMA(0, 0, At, B0); PG8_BAR; PG8_SCHED;
            PG8_LDB(B1, 1, 1); PG8_STAGE(PG8_SB(1, 0), b3, voffB);
            PG8_BAR; PG8_WAIT_L(0); PG8_MMA(0, 1, At, B1); PG8_BAR;
            PG8_LDA(At, 1, 1); PG8_STAGE(PG8_SA(1, 0), a3, voffA);
            PG8_BAR; PG8_WAIT_L(0); PG8_MMA(1, 0, At, B0); PG8_BAR; PG8_SCHED;
            PG8_STAGE(PG8_SB(1, 1), b3 + hstep, voffB);
            PG8_WAIT_V(6); PG8_BAR; PG8_MMA(1, 1, At, B1); PG8_BAR;
            }
        }
        if constexpr (ALIGN_EPI) { if (wr == 0) PG8_BAR; }
        if constexpr (!Epi::AFTER_DRAIN) { E(acc, cur, wr, wc, fr, fq); S.done(cur); }
        if (!has_next) break;
#pragma unroll
        for (int a = 0; a < 2; ++a)
#pragma unroll
            for (int b = 0; b < 2; ++b)
#pragma unroll
                for (int m = 0; m < 4; ++m)
#pragma unroll
                    for (int n = 0; n < 2; ++n) acc[a][b][m][n] = (f32x4){0.f, 0.f, 0.f, 0.f};
        cur = nxt; cA = nA; cB = nB; ++ui;
        if constexpr (ALIGN_EPI) { if (wr == 1) PG8_BAR; }
    }
    PG8_WAIT_V(0);
    if constexpr (!ALIGN_EPI) { if (wr == 0) PG8_BAR; }
    PG8_BAR;
    if constexpr (Epi::AFTER_DRAIN) { E.fused(acc, cur, wr, wc, fr, fq, lds, wid, lane); S.done(cur); }
#undef PG8_SA
#undef PG8_SB
#undef PG8_STAGE
#undef PG8_LDA
#undef PG8_LDB
#undef PG8_MMA
#undef PG8_WAIT_V
#undef PG8_WAIT_L
#undef PG8_BAR
#undef PG8_SCHED
}
}

#define LAS __attribute__((address_space(3)))
typedef unsigned short bf16_t;
typedef short bf16x8 __attribute__((ext_vector_type(8)));
typedef short s16x4 __attribute__((ext_vector_type(4)));
typedef float f32x4 __attribute__((ext_vector_type(4)));
typedef float f32x16 __attribute__((ext_vector_type(16)));
typedef unsigned u32x4 __attribute__((ext_vector_type(4)));
typedef unsigned u32x2 __attribute__((ext_vector_type(2)));

constexpr int SEQ = 16384, DM = 1024, DIN = 8608, NWAVES = 8;
constexpr float LOG2E = 1.4426950408889634f;
constexpr float EPS = 1e-6f;
constexpr float NEGB = -1e30f;
constexpr size_t MiB = 1u << 20;
constexpr size_t WS_WIN = 0;
constexpr size_t WS_WUQ = WS_WIN + (size_t)8704 * 1024 * 2;
constexpr size_t WS_WUKV = WS_WUQ + (size_t)1536 * 256 * 2;
constexpr size_t WS_WA = WS_WUKV + (size_t)2048 * 128 * 2;
constexpr size_t WS_WB = WS_WA + (size_t)1024 * 512 * 2;
constexpr size_t WS_WO = WS_WB + (size_t)1024 * 1024 * 2;
static_assert(WS_WO + (size_t)1024 * 1024 * 2 <= 24 * MiB, "weights region");
constexpr size_t WS_MOD = 24 * MiB;
constexpr size_t WS_BT = WS_MOD + 32768;
constexpr size_t WS_SSQ = WS_BT + 32768;
constexpr size_t WS_SSKV = WS_SSQ + (size_t)SEQ * 16;
constexpr size_t WS_COS = 25 * MiB;
constexpr size_t WS_SIN = 26 * MiB;
constexpr size_t WS_H = 27 * MiB;
constexpr size_t WS_ZA = WS_H + 32 * MiB;
constexpr size_t WS_ZM = WS_ZA + 16 * MiB;
constexpr size_t WS_CQ = WS_ZM + 32 * MiB;
constexpr size_t WS_CKV = WS_CQ + 8 * MiB;
constexpr size_t WS_KR = WS_CKV + 4 * MiB;
constexpr size_t WS_BIG = WS_KR + 1 * MiB;
constexpr size_t WS_END = WS_BIG + 144 * MiB;
constexpr size_t GSZ = (size_t)SEQ * 512;
constexpr int LDS_BYTES = 147456;
constexpr size_t WS_BAR = WS_MOD + 640 * 1024;
constexpr int LDS_ST = 139264;

__device__ __forceinline__ float fast_exp2(float x) { return __builtin_amdgcn_exp2f(x); }
__device__ __forceinline__ float fast_rcp(float x) { return __builtin_amdgcn_rcpf(x); }
__device__ __forceinline__ float silu_f(float v) { return v * fast_rcp(1.f + fast_exp2(-v * LOG2E)); }
__device__ __forceinline__ float sigm_f(float v) { return fast_rcp(1.f + fast_exp2(-v * LOG2E)); }
__device__ __forceinline__ float bf2f(unsigned short b) { return __uint_as_float((unsigned)b << 16); }
__device__ __forceinline__ float bflo(unsigned w) { return __uint_as_float(w << 16); }
__device__ __forceinline__ float bfhi(unsigned w) { return __uint_as_float(w & 0xffff0000u); }
using pg8::cvt_pk_bf16;
__device__ __forceinline__ u32x4 pack8(const f32x4& a, const f32x4& b) { u32x4 w; w.x = cvt_pk_bf16(a[0], a[1]); w.y = cvt_pk_bf16(a[2], a[3]); w.z = cvt_pk_bf16(b[0], b[1]); w.w = cvt_pk_bf16(b[2], b[3]); return w; }

struct EpiIn {
    static constexpr bool PERM = true, AFTER_DRAIN = false;
    bf16_t* BIG; bf16_t* ZA; bf16_t* ZM; bf16_t* CQ; bf16_t* CKV; bf16_t* KR; float* SSQ; float* SSKV; const float* COS; const float* SIN;
    __device__ __forceinline__ void operator()(const f32x4 (&acc)[2][2][4][2], const pg8::Unit& u, int wr, int wc, int fr, int fq) const {
        const int pn = u.pn; const int rowb = u.pm * 256 + wr * 64 + fr; const int cb = wc * 32 + 8 * fq;
        if (pn < 18) {
            const int which = pn / 6, g = (pn % 6) >> 1, half = pn & 1, sh = 2 * g;
            bf16_t* base = BIG + (size_t)(which * 3 + g) * GSZ + half * 256 + cb;
            const float sc = which == 0 ? 0.125f * LOG2E : 1.f;
#pragma unroll
            for (int ai = 0; ai < 2; ++ai)
#pragma unroll
                for (int m = 0; m < 4; ++m) { const int t = rowb + ai * 128 + m * 16; const int rho = (t & ((1 << sh) - 1)) * (SEQ >> sh) + (t >> sh);
#pragma unroll
                    for (int bj = 0; bj < 2; ++bj) *(u32x4*)(base + (size_t)rho * 512 + bj * 128) = pack8(acc[ai][bj][m][0] * sc, acc[ai][bj][m][1] * sc); }
        } else if (pn < 20 || pn >= 22) {
            bf16_t* base = pn < 20 ? ZA + (pn - 18) * 256 + cb : ZM + (pn - 22) * 256 + cb; const int ld = pn < 20 ? 512 : 1024;
#pragma unroll
            for (int ai = 0; ai < 2; ++ai)
#pragma unroll
                for (int m = 0; m < 4; ++m) { const int t = rowb + ai * 128 + m * 16;
#pragma unroll
                    for (int bj = 0; bj < 2; ++bj) { f32x4 a = acc[ai][bj][m][0], b = acc[ai][bj][m][1];
#pragma unroll
                        for (int j = 0; j < 4; ++j) { a[j] = silu_f(a[j]); b[j] = silu_f(b[j]); }
                        *(u32x4*)(base + (size_t)t * ld + bj * 128) = pack8(a, b); } }
        } else if (pn == 20) {
#pragma unroll
            for (int ai = 0; ai < 2; ++ai)
#pragma unroll
                for (int m = 0; m < 4; ++m) { const int t = rowb + ai * 128 + m * 16; float s = 0.f;
#pragma unroll
                    for (int bj = 0; bj < 2; ++bj) { const f32x4 a = acc[ai][bj][m][0], b = acc[ai][bj][m][1];
                        s += (a[0] * a[0] + a[1] * a[1]) + (a[2] * a[2] + a[3] * a[3]) + (b[0] * b[0] + b[1] * b[1]) + (b[2] * b[2] + b[3] * b[3]);
                        *(u32x4*)(CQ + (size_t)t * 256 + bj * 128 + cb) = pack8(a, b); }
                    s += __shfl_xor(s, 16); s += __shfl_xor(s, 32);
                    if (fq == 0) SSQ[(size_t)t * 4 + wc] = s; }
        } else {
#pragma unroll
            for (int ai = 0; ai < 2; ++ai)
#pragma unroll
                for (int m = 0; m < 4; ++m) { const int t = rowb + ai * 128 + m * 16;
                    const f32x4 a = acc[ai][0][m][0], b = acc[ai][0][m][1];
                    float s = (a[0] * a[0] + a[1] * a[1]) + (a[2] * a[2] + a[3] * a[3]) + (b[0] * b[0] + b[1] * b[1]) + (b[2] * b[2] + b[3] * b[3]);
                    *(u32x4*)(CKV + (size_t)t * 128 + cb) = pack8(a, b);
                    s += __shfl_xor(s, 16); s += __shfl_xor(s, 32);
                    if (fq == 0) SSKV[(size_t)t * 4 + wc] = s;
                    if (wc == 0) { const f32x4 t1 = acc[ai][1][m][0], t2 = acc[ai][1][m][1];
                        const f32x4 c = *(const f32x4*)(COS + (size_t)t * 16 + 4 * fq), sn = *(const f32x4*)(SIN + (size_t)t * 16 + 4 * fq);
                        const f32x4 o1 = t1 * c - t2 * sn, o2 = t1 * sn + t2 * c;
                        u32x2 w1, w2; w1.x = cvt_pk_bf16(o1[0], o1[1]); w1.y = cvt_pk_bf16(o1[2], o1[3]); w2.x = cvt_pk_bf16(o2[0], o2[1]); w2.y = cvt_pk_bf16(o2[2], o2[3]);
                        *(u32x2*)(KR + (size_t)t * 32 + 4 * fq) = w1; *(u32x2*)(KR + (size_t)t * 32 + 16 + 4 * fq) = w2; }
                    asm volatile("" ::: "memory"); }
        }
    }
};
struct EpiUq {
    static constexpr bool PERM = true, AFTER_DRAIN = false;
    bf16_t* Qm; const float* SSQ; const float* COS; const float* SIN;
    __device__ __forceinline__ void operator()(const f32x4 (&acc)[2][2][4][2], const pg8::Unit& u, int wr, int wc, int fr, int fq) const {
        const int pn = u.pn; const int rowb = u.pm * 256 + wr * 64 + fr;
        const float C2 = 0.10206207261596577f * LOG2E;
#pragma unroll
        for (int ai = 0; ai < 2; ++ai)
#pragma unroll
            for (int m = 0; m < 4; ++m) { const int t = rowb + ai * 128 + m * 16;
                const f32x4 ss = *(const f32x4*)(SSQ + (size_t)t * 4);
                const float f = __builtin_amdgcn_rsqf(((ss[0] + ss[1]) + (ss[2] + ss[3])) * (1.f / 256.f) + EPS) * C2;
                if (pn < 4) {
#pragma unroll
                    for (int bj = 0; bj < 2; ++bj) { const int gc = pn * 256 + bj * 128 + wc * 32 + 8 * fq;
                        *(u32x4*)(Qm + (size_t)t * 1536 + (gc >> 6) * 96 + (gc & 63)) = pack8(acc[ai][bj][m][0] * f, acc[ai][bj][m][1] * f); }
                } else {
                    const f32x4 c = *(const f32x4*)(COS + (size_t)t * 16 + 4 * fq), sn = *(const f32x4*)(SIN + (size_t)t * 16 + 4 * fq);
#pragma unroll
                    for (int bj = 0; bj < 2; ++bj) { const int head = (pn - 4) * 8 + bj * 4 + wc;
                        const f32x4 t1 = acc[ai][bj][m][0] * f, t2 = acc[ai][bj][m][1] * f;
                        const f32x4 o1 = t1 * c - t2 * sn, o2 = t1 * sn + t2 * c;
                        u32x2 w1, w2; w1.x = cvt_pk_bf16(o1[0], o1[1]); w1.y = cvt_pk_bf16(o1[2], o1[3]); w2.x = cvt_pk_bf16(o2[0], o2[1]); w2.y = cvt_pk_bf16(o2[2], o2[3]);
                        bf16_t* p = Qm + (size_t)t * 1536 + head * 96 + 64 + 4 * fq;
                        *(u32x2*)p = w1; *(u32x2*)(p + 16) = w2; }
                }
                if (m & 1) asm volatile("" ::: "memory"); }
    }
};
struct EpiUkv {
    static constexpr bool PERM = true, AFTER_DRAIN = false;
    bf16_t* Km; bf16_t* Vm; const float* SSKV;
    __device__ __forceinline__ void operator()(const f32x4 (&acc)[2][2][4][2], const pg8::Unit& u, int wr, int wc, int fr, int fq) const {
        const int pn = u.pn; const int rowb = u.pm * 256 + wr * 64 + fr; const int cb = wc * 32 + 8 * fq;
        bf16_t* base = (pn < 4 ? Km + pn * 256 : Vm + (pn - 4) * 256) + cb;
#pragma unroll
        for (int ai = 0; ai < 2; ++ai)
#pragma unroll
            for (int m = 0; m < 4; ++m) { const int t = rowb + ai * 128 + m * 16;
                const f32x4 ss = *(const f32x4*)(SSKV + (size_t)t * 4);
                const float f = __builtin_amdgcn_rsqf(((ss[0] + ss[1]) + (ss[2] + ss[3])) * (1.f / 128.f) + EPS);
#pragma unroll
                for (int bj = 0; bj < 2; ++bj) *(u32x4*)(base + (size_t)t * 1024 + bj * 128) = pack8(acc[ai][bj][m][0] * f, acc[ai][bj][m][1] * f);
                if (m & 1) asm volatile("" ::: "memory"); }
    }
};
struct EpiRes {
    static constexpr bool PERM = false, AFTER_DRAIN = false;
    const float* xin; float* out; const float* gate;
    __device__ __forceinline__ void operator()(const f32x4 (&acc)[2][2][4][2], const pg8::Unit& u, int wr, int wc, int fr, int fq) const {
        const int rowb = u.pm * 256 + wr * 64 + fr; const int c0 = u.pn * 256 + wc * 32 + 4 * fq;
        f32x4 gv[2][2];
#pragma unroll
        for (int bj = 0; bj < 2; ++bj)
#pragma unroll
            for (int n = 0; n < 2; ++n) gv[bj][n] = *(const f32x4*)(gate + c0 + bj * 128 + n * 16);
#pragma unroll
        for (int ai = 0; ai < 2; ++ai)
#pragma unroll
            for (int m = 0; m < 4; ++m) { const int t = rowb + ai * 128 + m * 16;
#pragma unroll
                for (int bj = 0; bj < 2; ++bj)
#pragma unroll
                    for (int n = 0; n < 2; ++n) { const size_t off = (size_t)t * 1024 + c0 + bj * 128 + n * 16;
                        const f32x4 xv = *(const f32x4*)(xin + off); *(f32x4*)(out + off) = xv + gv[bj][n] * acc[ai][bj][m][n]; }
                if (m == 3) asm volatile("" ::: "memory"); }
    }
};


#define GEMM_PHASE(EPI, lds, g, S, E) pg8::gemm_phase<EPI, pg8::StaticOrder, true, true>(lds, g, S, E)


constexpr int P4_PITCH = 144, P4_OPB = 128 * P4_PITCH, P4_BUF = 2 * P4_OPB;
__device__ __forceinline__ void p4_pass(const bf16_t* __restrict__ A, int K, const bf16_t* __restrict__ B, int rt, int ct, f32x16& c0, f32x16& c1, LAS char* lds, int tid, int r32, int hi, int wa, int wb) {
    const bf16_t* asrc = A + (size_t)(rt * 128 + (tid >> 2)) * K + (tid & 3) * 8;
    const bf16_t* bsrc = B + (size_t)(ct * 128 + (tid >> 2)) * K + (tid & 3) * 8;
    const int sdst = (tid >> 2) * P4_PITCH + (tid & 3) * 16;
    const int xoff = (wa * 32 + r32) * P4_PITCH + hi * 16, woff = P4_OPB + (wb * 64 + r32) * P4_PITCH + hi * 16;
    const int nk = K >> 6;
    u32x4 ga0 = *(const u32x4*)asrc, ha0 = *(const u32x4*)(asrc + 32), gb0 = *(const u32x4*)bsrc, hb0 = *(const u32x4*)(bsrc + 32), ga1, ha1, gb1, hb1;
    *(LAS u32x4*)(lds + sdst) = ga0; *(LAS u32x4*)(lds + sdst + 64) = ha0; *(LAS u32x4*)(lds + P4_OPB + sdst) = gb0; *(LAS u32x4*)(lds + P4_OPB + sdst + 64) = hb0;
    ga1 = *(const u32x4*)(asrc + 64); ha1 = *(const u32x4*)(asrc + 96); gb1 = *(const u32x4*)(bsrc + 64); hb1 = *(const u32x4*)(bsrc + 96);
    __syncthreads();
    c0 = (f32x16){}; c1 = (f32x16){};
#define P4_STEP(kt, GA_LD, HA_LD, GB_LD, HB_LD, GA_ST, HA_ST, GB_ST, HB_ST) do { \
        const LAS char* buf = lds + ((kt) & 1) * P4_BUF; \
        if ((kt) + 2 < nk) { GA_LD = *(const u32x4*)(asrc + ((kt) + 2) * 64); HA_LD = *(const u32x4*)(asrc + ((kt) + 2) * 64 + 32); GB_LD = *(const u32x4*)(bsrc + ((kt) + 2) * 64); HB_LD = *(const u32x4*)(bsrc + ((kt) + 2) * 64 + 32); } \
        _Pragma("unroll") for (int s = 0; s < 4; ++s) { \
            const bf16x8 x = *(const LAS bf16x8*)(buf + xoff + s * 32); \
            const bf16x8 w0 = *(const LAS bf16x8*)(buf + woff + s * 32), w1 = *(const LAS bf16x8*)(buf + woff + 32 * P4_PITCH + s * 32); \
            c0 = __builtin_amdgcn_mfma_f32_32x32x16_bf16(w0, x, c0, 0, 0, 0); c1 = __builtin_amdgcn_mfma_f32_32x32x16_bf16(w1, x, c1, 0, 0, 0); } \
        if ((kt) + 1 < nk) { LAS char* nb = lds + (((kt) + 1) & 1) * P4_BUF; *(LAS u32x4*)(nb + sdst) = GA_ST; *(LAS u32x4*)(nb + sdst + 64) = HA_ST; *(LAS u32x4*)(nb + P4_OPB + sdst) = GB_ST; *(LAS u32x4*)(nb + P4_OPB + sdst + 64) = HB_ST; } \
        __syncthreads(); } while (0)
    for (int kt = 0; kt < nk; kt += 2) {
        P4_STEP(kt, ga0, ha0, gb0, hb0, ga1, ha1, gb1, hb1);
        P4_STEP(kt + 1, ga1, ha1, gb1, hb1, ga0, ha0, gb0, hb0);
    }
#undef P4_STEP
}
constexpr int P4_BUF2 = 3 * P4_OPB;
__device__ __forceinline__ void p4_pass2(const bf16_t* __restrict__ A, int K, const bf16_t* __restrict__ B0, const bf16_t* __restrict__ B1, int rt, int ct, f32x16& a0, f32x16& a1, f32x16& m0, f32x16& m1, LAS char* lds, int tid, int r32, int hi, int wa, int wb) {
    const bf16_t* asrc = A + (size_t)(rt * 128 + (tid >> 2)) * K + (tid & 3) * 8;
    const bf16_t* bsrc = B0 + (size_t)(ct * 128 + (tid >> 2)) * K + (tid & 3) * 8;
    const bf16_t* csrc = B1 + (size_t)(ct * 128 + (tid >> 2)) * K + (tid & 3) * 8;
    const int sdst = (tid >> 2) * P4_PITCH + (tid & 3) * 16;
    const int xoff = (wa * 32 + r32) * P4_PITCH + hi * 16, woff = P4_OPB + (wb * 64 + r32) * P4_PITCH + hi * 16;
    const int nk = K >> 6;
    u32x4 rA[6], rB[6];
#define P4_LD2(kt, R) do { R[0] = *(const u32x4*)(asrc + (kt) * 64); R[1] = *(const u32x4*)(asrc + (kt) * 64 + 32); R[2] = *(const u32x4*)(bsrc + (kt) * 64); R[3] = *(const u32x4*)(bsrc + (kt) * 64 + 32); \
        R[4] = *(const u32x4*)(csrc + (kt) * 64); R[5] = *(const u32x4*)(csrc + (kt) * 64 + 32); } while (0)
#define P4_ST2(boff, R) do { LAS char* nb_ = lds + (boff); *(LAS u32x4*)(nb_ + sdst) = R[0]; *(LAS u32x4*)(nb_ + sdst + 64) = R[1]; *(LAS u32x4*)(nb_ + P4_OPB + sdst) = R[2]; *(LAS u32x4*)(nb_ + P4_OPB + sdst + 64) = R[3]; \
        *(LAS u32x4*)(nb_ + 2 * P4_OPB + sdst) = R[4]; *(LAS u32x4*)(nb_ + 2 * P4_OPB + sdst + 64) = R[5]; } while (0)
    P4_LD2(0, rA); P4_ST2(0, rA); P4_LD2(1, rB);
    __syncthreads();
    a0 = (f32x16){}; a1 = (f32x16){}; m0 = (f32x16){}; m1 = (f32x16){};
#define P4_STEP2(kt, RL, RS) do { \
        const LAS char* buf = lds + ((kt) & 1) * P4_BUF2; \
        if ((kt) + 2 < nk) P4_LD2((kt) + 2, RL); \
        _Pragma("unroll") for (int s = 0; s < 4; ++s) { \
            const bf16x8 x = *(const LAS bf16x8*)(buf + xoff + s * 32); \
            const bf16x8 w0 = *(const LAS bf16x8*)(buf + woff + s * 32), w1 = *(const LAS bf16x8*)(buf + woff + 32 * P4_PITCH + s * 32); \
            const bf16x8 u0 = *(const LAS bf16x8*)(buf + P4_OPB + woff + s * 32), u1 = *(const LAS bf16x8*)(buf + P4_OPB + woff + 32 * P4_PITCH + s * 32); \
            a0 = __builtin_amdgcn_mfma_f32_32x32x16_bf16(w0, x, a0, 0, 0, 0); a1 = __builtin_amdgcn_mfma_f32_32x32x16_bf16(w1, x, a1, 0, 0, 0); \
            m0 = __builtin_amdgcn_mfma_f32_32x32x16_bf16(u0, x, m0, 0, 0, 0); m1 = __builtin_amdgcn_mfma_f32_32x32x16_bf16(u1, x, m1, 0, 0, 0); } \
        if ((kt) + 1 < nk) P4_ST2((((kt) + 1) & 1) * P4_BUF2, RS); \
        __syncthreads(); } while (0)
    for (int kt = 0; kt < nk; kt += 2) { P4_STEP2(kt, rA, rB); P4_STEP2(kt + 1, rB, rA); }
#undef P4_STEP2
#undef P4_LD2
#undef P4_ST2
}
__device__ __forceinline__ void p4_unit(int rt, int ct, const bf16_t* H, const bf16_t* YA, const bf16_t* YM, const bf16_t* Wga, const bf16_t* Wgm, const bf16_t* Wa, const bf16_t* Wb, bf16_t* MERGED, LAS char* lds) {
    int tid_ = threadIdx.x; asm volatile("" : "+v"(tid_)); const int tid = tid_, lane = tid & 63, r32 = lane & 31, hi = lane >> 5; const int wid = __builtin_amdgcn_readfirstlane(tid >> 6);
    const int wa = wid & 3, wb = wid >> 2;
    f32x16 g0, g1, m0, m1, c0, c1;
    p4_pass2(H, 1024, Wga, Wgm, rt, ct, g0, g1, m0, m1, lds, tid, r32, hi, wa, wb);
#pragma unroll
    for (int r = 0; r < 16; ++r) { g0[r] = sigm_f(g0[r]); g1[r] = sigm_f(g1[r]); m0[r] = sigm_f(m0[r]); m1[r] = sigm_f(m1[r]); }
    p4_pass(YA, 512, Wa, rt, ct, c0, c1, lds, tid, r32, hi, wa, wb);
    g0 *= c0; g1 *= c1;
    p4_pass(YM, 1024, Wb, rt, ct, c0, c1, lds, tid, r32, hi, wa, wb);
    g0 += m0 * c0; g1 += m1 * c1;
    bf16_t* op = MERGED + (size_t)(rt * 128 + wa * 32 + r32) * 1024 + ct * 128 + wb * 64 + 4 * hi;
#pragma unroll
    for (int g4 = 0; g4 < 4; ++g4) { u32x2 w; w.x = cvt_pk_bf16(g0[4 * g4], g0[4 * g4 + 1]); w.y = cvt_pk_bf16(g0[4 * g4 + 2], g0[4 * g4 + 3]); *(u32x2*)(op + 8 * g4) = w;
        u32x2 v; v.x = cvt_pk_bf16(g1[4 * g4], g1[4 * g4 + 1]); v.y = cvt_pk_bf16(g1[4 * g4 + 2], g1[4 * g4 + 3]); *(u32x2*)(op + 32 + 8 * g4) = v; }
}

__device__ __forceinline__ int crow(int r, int hi) { return (r & 3) + 8 * (r >> 2) + 4 * hi; }
__device__ __forceinline__ s16x4 vtr(const LAS char* p) { typedef short v4i16_t __attribute__((ext_vector_type(4))); return __builtin_bit_cast(s16x4, __builtin_amdgcn_ds_read_tr16_b64_v4i16((LAS v4i16_t*)p)); }
__device__ __forceinline__ bf16x8 cat8(s16x4 a, s16x4 b) { return (bf16x8){a[0], a[1], a[2], a[3], b[0], b[1], b[2], b[3]}; }
__device__ __forceinline__ bf16x8 packp(const f32x16& p, int b) { u32x4 w; w.x = cvt_pk_bf16(p[b], p[b + 1]); w.y = cvt_pk_bf16(p[b + 2], p[b + 3]); w.z = cvt_pk_bf16(p[b + 4], p[b + 5]); w.w = cvt_pk_bf16(p[b + 6], p[b + 7]); return __builtin_bit_cast(bf16x8, w); }
__device__ __forceinline__ float max3f(float a, float b, float c) { return fmaxf(fmaxf(a, b), c); }
__device__ __forceinline__ float max16(const f32x16& p) { float a = fmaxf(fmaxf(p[0], p[1]), fmaxf(p[2], p[3])), b = fmaxf(fmaxf(p[4], p[5]), fmaxf(p[6], p[7])), c = fmaxf(fmaxf(p[8], p[9]), fmaxf(p[10], p[11])), d = fmaxf(fmaxf(p[12], p[13]), fmaxf(p[14], p[15])); return fmaxf(fmaxf(a, b), fmaxf(c, d)); }

constexpr int KP = 208, VP = 192, KBUF = 64 * KP, VBUF = 64 * VP, STG = KBUF + VBUF;
__device__ __forceinline__ void mla_unit(int h, int qb, const bf16_t* __restrict__ Qm, const bf16_t* __restrict__ Km, const bf16_t* __restrict__ Kr, const bf16_t* __restrict__ Vm, bf16_t* ZM, LAS char* lds) {
    int tid_ = threadIdx.x; asm volatile("" : "+v"(tid_)); const int tid = tid_, lane = tid & 63, r32 = lane & 31, hi = lane >> 5; const int wid = __builtin_amdgcn_readfirstlane(tid >> 6);
    const int q0 = qb * 256, qrow = q0 + wid * 32 + r32;
    bf16x8 qf[6];
#pragma unroll
    for (int s = 0; s < 6; ++s) qf[s] = *(const bf16x8*)(Qm + (size_t)qrow * 1536 + h * 96 + 16 * s + 8 * hi);
    const int NT = (q0 + 256) / 64;
    const int srow = tid >> 3, sch = tid & 7, rrow = (tid & 255) >> 2, rch = tid & 3;
    const bf16_t* kn_src = Km + (size_t)srow * 1024 + h * 64 + sch * 8;
    const bf16_t* v_src = Vm + (size_t)srow * 1024 + h * 64 + sch * 8;
    const bf16_t* kr_src = Kr + (size_t)rrow * 32 + rch * 8;
    const int kn_dst = srow * KP + sch * 16, kr_dst = rrow * KP + 128 + rch * 16, v_dst = KBUF + srow * VP + sch * 16;
    u32x4 gknA, gkrA, gvA, gknB, gkrB, gvB;
    gknA = *(const u32x4*)kn_src; gvA = *(const u32x4*)v_src; gkrA = *(const u32x4*)kr_src;
    *(LAS u32x4*)(lds + kn_dst) = gknA; *(LAS u32x4*)(lds + v_dst) = gvA; if (tid < 256) *(LAS u32x4*)(lds + kr_dst) = gkrA;
    gknB = *(const u32x4*)(kn_src + (size_t)64 * 1024); gvB = *(const u32x4*)(v_src + (size_t)64 * 1024); gkrB = *(const u32x4*)(kr_src + (size_t)64 * 32);
    __syncthreads();
    float l = 0.f; f32x16 o0 = {}, o1 = {};
    const int ka_off = r32 * KP + hi * 16;
    const int i16 = lane & 15, dg = (lane >> 4) & 1;
    const int va_off = KBUF + (4 * hi + (i16 >> 2)) * VP + (16 * dg + 4 * (i16 & 3)) * 2;
    float mref = 0.f; f32x16 negm = {};
#define MLA_SB() __builtin_amdgcn_sched_barrier(0)
#define MLA_EX4(S, b) do { S[b] = fast_exp2(S[b]); S[b + 1] = fast_exp2(S[b + 1]); S[b + 2] = fast_exp2(S[b + 2]); S[b + 3] = fast_exp2(S[b + 3]); ps += (S[b] + S[b + 1]) + (S[b + 2] + S[b + 3]); } while (0)
#define MLA_STEP(t, GKN_LD, GV_LD, GKR_LD, GKN_ST, GV_ST, GKR_ST) do { \
        const LAS char* buf = lds + ((t) & 1) * STG; \
        { const size_t o = (size_t)((t) + 2 < NT ? (t) + 2 : NT - 1) * 64; GKN_LD = *(const u32x4*)(kn_src + o * 1024); GV_LD = *(const u32x4*)(v_src + o * 1024); GKR_LD = *(const u32x4*)(kr_src + o * 32); }     \
        const int jb = (t) - (NT - 4); \
        if (!(jb >= 0 && 2 * jb > wid)) { \
              \
            bf16x8 ka[6], kb[6]; \
            _Pragma("unroll") for (int s = 0; s < 6; ++s) ka[s] = *(const LAS bf16x8*)(buf + ka_off + s * 32); \
            MLA_SB(); \
            _Pragma("unroll") for (int s = 0; s < 6; ++s) kb[s] = *(const LAS bf16x8*)(buf + ka_off + 32 * KP + s * 32); \
            MLA_SB(); \
            f32x16 s0 = negm, s1 = negm; float ps = 0.f; \
            __builtin_amdgcn_s_setprio(1); \
              \
            s0 = __builtin_amdgcn_mfma_f32_32x32x16_bf16(ka[0], qf[0], s0, 0, 0, 0); s1 = __builtin_amdgcn_mfma_f32_32x32x16_bf16(kb[0], qf[0], s1, 0, 0, 0); \
            s0 = __builtin_amdgcn_mfma_f32_32x32x16_bf16(ka[1], qf[1], s0, 0, 0, 0); s1 = __builtin_amdgcn_mfma_f32_32x32x16_bf16(kb[1], qf[1], s1, 0, 0, 0); \
            MLA_SB(); \
            const LAS char* vp0 = buf + va_off; \
            s16x4 v0[8]; \
            _Pragma("unroll") for (int ks = 0; ks < 2; ++ks) { v0[4 * ks] = vtr(vp0 + ks * 16 * VP); v0[4 * ks + 1] = vtr(vp0 + ks * 16 * VP + 8 * VP); v0[4 * ks + 2] = vtr(vp0 + ks * 16 * VP + 64); v0[4 * ks + 3] = vtr(vp0 + ks * 16 * VP + 8 * VP + 64); } \
            _Pragma("unroll") for (int s = 2; s < 6; ++s) s0 = __builtin_amdgcn_mfma_f32_32x32x16_bf16(ka[s], qf[s], s0, 0, 0, 0); \
            MLA_SB(); \
            if (jb >= 0) { _Pragma("unroll") for (int r = 0; r < 16; ++r) { const int kv = 64 * (t) + crow(r, hi); if (kv > qrow) s0[r] = NEGB; } } \
            float ra = max3f(s0[0], s0[1], s0[2]); ra = max3f(ra, s0[3], s0[4]); ra = max3f(ra, s0[5], s0[6]); ra = max3f(ra, s0[7], s0[8]); ra = max3f(ra, s0[9], s0[10]); ra = max3f(ra, s0[11], s0[12]); ra = max3f(ra, s0[13], s0[14]); ra = fmaxf(ra, s0[15]); \
            s1 = __builtin_amdgcn_mfma_f32_32x32x16_bf16(kb[2], qf[2], s1, 0, 0, 0); MLA_EX4(s0, 0); MLA_SB(); \
            s1 = __builtin_amdgcn_mfma_f32_32x32x16_bf16(kb[3], qf[3], s1, 0, 0, 0); MLA_EX4(s0, 4); MLA_SB(); \
            bf16x8 pb0, pb1; \
            s1 = __builtin_amdgcn_mfma_f32_32x32x16_bf16(kb[4], qf[4], s1, 0, 0, 0); MLA_EX4(s0, 8); pb0 = packp(s0, 0); MLA_SB(); \
            s1 = __builtin_amdgcn_mfma_f32_32x32x16_bf16(kb[5], qf[5], s1, 0, 0, 0); MLA_EX4(s0, 12); MLA_SB(); \
            pb1 = packp(s0, 8); \
            __builtin_amdgcn_s_setprio(0); \
            s16x4 v1[8];                                                       \
            _Pragma("unroll") for (int ks = 0; ks < 2; ++ks) { v1[4 * ks] = vtr(vp0 + (ks + 2) * 16 * VP); v1[4 * ks + 1] = vtr(vp0 + (ks + 2) * 16 * VP + 8 * VP); v1[4 * ks + 2] = vtr(vp0 + (ks + 2) * 16 * VP + 64); v1[4 * ks + 3] = vtr(vp0 + (ks + 2) * 16 * VP + 8 * VP + 64); } \
            MLA_SB(); \
            if (jb >= 0) { _Pragma("unroll") for (int r = 0; r < 16; ++r) { const int kv = 64 * (t) + crow(r, hi); if (kv + 32 > qrow) s1[r] = NEGB; } } \
            float rb = max3f(s1[0], s1[1], s1[2]); rb = max3f(rb, s1[3], s1[4]); rb = max3f(rb, s1[5], s1[6]); rb = max3f(rb, s1[7], s1[8]); rb = max3f(rb, s1[9], s1[10]); rb = max3f(rb, s1[11], s1[12]); rb = max3f(rb, s1[13], s1[14]); rb = fmaxf(rb, s1[15]); \
            float rm = fmaxf(ra, rb); { const auto rr_ = __builtin_amdgcn_permlane32_swap(__float_as_uint(rm), __float_as_uint(rm), false, false); rm = fmaxf(__uint_as_float(rr_[0]), __uint_as_float(rr_[1])); }     \
            if ((t) == 0 || __any(rm > 8.0f)) { \
                const float dl = (t) == 0 ? rm : fmaxf(rm, 0.f); mref += dl; const float f = fast_exp2(-dl); \
                _Pragma("unroll") for (int r = 0; r < 16; ++r) { s0[r] *= f; s1[r] -= dl; negm[r] = -mref; } \
                ps *= f; l *= f; o0 *= f; o1 *= f; pb0 = packp(s0, 0); pb1 = packp(s0, 8); } \
            MLA_SB(); \
            __builtin_amdgcn_s_setprio(1); \
            o0 = __builtin_amdgcn_mfma_f32_32x32x16_bf16(cat8(v0[0], v0[1]), pb0, o0, 0, 0, 0); MLA_EX4(s1, 0); MLA_SB(); \
            o1 = __builtin_amdgcn_mfma_f32_32x32x16_bf16(cat8(v0[2], v0[3]), pb0, o1, 0, 0, 0); MLA_EX4(s1, 4); MLA_SB(); \
            bf16x8 pb2; \
            o0 = __builtin_amdgcn_mfma_f32_32x32x16_bf16(cat8(v0[4], v0[5]), pb1, o0, 0, 0, 0); MLA_EX4(s1, 8); pb2 = packp(s1, 0); MLA_SB(); \
            o1 = __builtin_amdgcn_mfma_f32_32x32x16_bf16(cat8(v0[6], v0[7]), pb1, o1, 0, 0, 0); MLA_EX4(s1, 12); MLA_SB(); \
            l += ps; \
            const bf16x8 pb3 = packp(s1, 8); \
            MLA_SB(); \
            o0 = __builtin_amdgcn_mfma_f32_32x32x16_bf16(cat8(v1[0], v1[1]), pb2, o0, 0, 0, 0); o1 = __builtin_amdgcn_mfma_f32_32x32x16_bf16(cat8(v1[2], v1[3]), pb2, o1, 0, 0, 0); \
            o0 = __builtin_amdgcn_mfma_f32_32x32x16_bf16(cat8(v1[4], v1[5]), pb3, o0, 0, 0, 0); o1 = __builtin_amdgcn_mfma_f32_32x32x16_bf16(cat8(v1[6], v1[7]), pb3, o1, 0, 0, 0); \
            __builtin_amdgcn_s_setprio(0); \
            MLA_SB(); \
        } \
        if ((t) + 1 < NT) { LAS char* nb = lds + (((t) + 1) & 1) * STG; *(LAS u32x4*)(nb + kn_dst) = GKN_ST; *(LAS u32x4*)(nb + v_dst) = GV_ST; if (tid < 256) *(LAS u32x4*)(nb + kr_dst) = GKR_ST; } \
        __syncthreads(); } while (0)
    for (int t = 0; t < NT; t += 2) {
        MLA_STEP(t, gknA, gvA, gkrA, gknB, gvB, gkrB);
        MLA_STEP(t + 1, gknB, gvB, gkrB, gknA, gvA, gkrA);
    }
#undef MLA_STEP
#undef MLA_EX4
#undef MLA_SB
    l += __shfl_xor(l, 32); const float rl = fast_rcp(l);
    bf16_t* zp = ZM + (size_t)qrow * 1024 + h * 64 + 4 * hi;
#pragma unroll
    for (int db = 0; db < 2; ++db)
#pragma unroll
        for (int g4 = 0; g4 < 4; ++g4) { bf16_t* p = zp + 32 * db + 8 * g4; const u32x2 z = *(const u32x2*)p; const f32x16& o = db ? o1 : o0;
            u32x2 w; w.x = cvt_pk_bf16(o[4 * g4] * rl * bflo(z.x), o[4 * g4 + 1] * rl * bfhi(z.x)); w.y = cvt_pk_bf16(o[4 * g4 + 2] * rl * bflo(z.y), o[4 * g4 + 3] * rl * bfhi(z.y));
            *(u32x2*)p = w; }
}

constexpr int DL_V = 0, DL_LSE = 8 * 32 * VP, DL_TAB = DL_LSE + 3 * 512 * 4;
__device__ __forceinline__ void dil_unit(int hs, int un, bf16_t* BIG, bf16_t* ZA, const float* __restrict__ BT, LAS char* lds) {
    int tid_ = threadIdx.x; asm volatile("" : "+v"(tid_)); const int tid = tid_, lane = tid & 63, r32 = lane & 31, hi = lane >> 5; const int wid = __builtin_amdgcn_readfirstlane(tid >> 6);
    const int T0 = un * 512;
    LAS float* lse_l = (LAS float*)(lds + DL_LSE); LAS float* tab = (LAS float*)(lds + DL_TAB);
    for (int i = tid; i < 576; i += 512) tab[i] = BT[((i / 192) * 8 + hs) * 192 + (i % 192)];
    __syncthreads();
    LAS char* vst = lds + DL_V + wid * 32 * VP;
    const int i16 = lane & 15, dg = (lane >> 4) & 1;
    const int va_off = (4 * hi + (i16 >> 2)) * VP + (16 * dg + 4 * (i16 & 3)) * 2;
    for (int k = 0; k < 6; ++k) {
        const int item = wid + 8 * k, g = item >> 4, b = item & 15, sh = 2 * g, L = SEQ >> sh;
        const int p = b >> (4 - sh), sub = b & ((16 >> sh) - 1), m0 = (T0 >> sh) + 32 * sub;
        const size_t rowbase = (size_t)p * L;
        bf16_t* Qg = BIG + (size_t)(0 * 3 + g) * GSZ; const bf16_t* Kg = BIG + (size_t)(1 * 3 + g) * GSZ; const bf16_t* Vg = BIG + (size_t)(2 * 3 + g) * GSZ;
        const size_t qrow = rowbase + m0 + r32;
        bf16x8 qf[4];
#pragma unroll
        for (int s = 0; s < 4; ++s) qf[s] = *(const bf16x8*)(Qg + qrow * 512 + hs * 64 + 16 * s + 8 * hi);
        float mrun = NEGB, l = 0.f; f32x16 o0 = {}, o1 = {};
        const LAS float* tg = tab + g * 192;
        for (int c = 0; c < 5; ++c) {
            const int ks0 = m0 - 128 + 32 * c; if (ks0 < 0) continue;
            const bf16_t* kp = Kg + (rowbase + ks0 + r32) * 512 + hs * 64 + 8 * hi;
            bf16x8 ka[4];
#pragma unroll
            for (int s = 0; s < 4; ++s) ka[s] = *(const bf16x8*)(kp + 16 * s);
            u32x4 vv[4];
#pragma unroll
            for (int i = 0; i < 4; ++i) vv[i] = *(const u32x4*)(Vg + (rowbase + ks0 + (lane >> 3) + 8 * i) * 512 + hs * 64 + (lane & 7) * 8);
            f32x16 sc = {};
#pragma unroll
            for (int s = 0; s < 4; ++s) sc = __builtin_amdgcn_mfma_f32_32x32x16_bf16(ka[s], qf[s], sc, 0, 0, 0);
#pragma unroll
            for (int r = 0; r < 16; ++r) sc[r] += tg[160 - 32 * c + r32 - crow(r, hi)];
            float rm = max16(sc); rm = fmaxf(rm, __shfl_xor(rm, 32));
            const float mn = fmaxf(mrun, rm), alpha = fast_exp2(mrun - mn); mrun = mn;
            float ps = 0.f;
#pragma unroll
            for (int r = 0; r < 16; ++r) { sc[r] = fast_exp2(sc[r] - mn); ps += sc[r]; }
            l = l * alpha + ps; o0 *= alpha; o1 *= alpha;
            const bf16x8 pb0 = packp(sc, 0), pb1 = packp(sc, 8);
#pragma unroll
            for (int i = 0; i < 4; ++i) *(LAS u32x4*)(vst + ((lane >> 3) + 8 * i) * VP + (lane & 7) * 16) = vv[i];
            asm volatile("s_waitcnt lgkmcnt(0)" ::: "memory");
#pragma unroll
            for (int ks = 0; ks < 2; ++ks) { const bf16x8 pb = ks == 0 ? pb0 : pb1;
                const LAS char* vp = vst + va_off + ks * 16 * VP;
                const bf16x8 a0 = cat8(vtr(vp), vtr(vp + 8 * VP)), a1 = cat8(vtr(vp + 64), vtr(vp + 8 * VP + 64));
                o0 = __builtin_amdgcn_mfma_f32_32x32x16_bf16(a0, pb, o0, 0, 0, 0); o1 = __builtin_amdgcn_mfma_f32_32x32x16_bf16(a1, pb, o1, 0, 0, 0); }
            asm volatile("s_waitcnt lgkmcnt(0)" ::: "memory");
        }
        l += __shfl_xor(l, 32); const float rl = fast_rcp(l);
        if (hi == 0) lse_l[g * 512 + ((m0 + r32) << sh) + p - T0] = mrun + __builtin_amdgcn_logf(l);
        bf16_t* op = Qg + qrow * 512 + hs * 64 + 4 * hi;
#pragma unroll
        for (int db = 0; db < 2; ++db)
#pragma unroll
            for (int g4 = 0; g4 < 4; ++g4) { const f32x16& o = db ? o1 : o0;
                u32x2 w; w.x = cvt_pk_bf16(o[4 * g4] * rl, o[4 * g4 + 1] * rl); w.y = cvt_pk_bf16(o[4 * g4 + 2] * rl, o[4 * g4 + 3] * rl);
                *(u32x2*)(op + 32 * db + 8 * g4) = w; }
    }
    __syncthreads();
#pragma unroll 2
    for (int k = 0; k < 8; ++k) {
        const int piece = tid + 512 * k, tl = piece >> 3, ch = piece & 7, t = T0 + tl;
        const float l0 = lse_l[tl], l1 = lse_l[512 + tl], l2 = lse_l[1024 + tl];
        const float mx = fmaxf(l0, fmaxf(l1, l2));
        float w0 = fast_exp2(l0 - mx), w1 = fast_exp2(l1 - mx), w2 = fast_exp2(l2 - mx); const float rs = fast_rcp(w0 + w1 + w2); w0 *= rs; w1 *= rs; w2 *= rs;
        const u32x4 a = *(const u32x4*)(BIG + (size_t)t * 512 + hs * 64 + ch * 8);
        const u32x4 bq = *(const u32x4*)(BIG + GSZ + ((size_t)(t & 3) * (SEQ >> 2) + (t >> 2)) * 512 + hs * 64 + ch * 8);
        const u32x4 cq = *(const u32x4*)(BIG + 2 * GSZ + ((size_t)(t & 15) * (SEQ >> 4) + (t >> 4)) * 512 + hs * 64 + ch * 8);
        bf16_t* zp = ZA + (size_t)t * 512 + hs * 64 + ch * 8; const u32x4 z = *(const u32x4*)zp;
        u32x4 w;
#define CMB(f) w.f = cvt_pk_bf16((w0 * bflo(a.f) + w1 * bflo(bq.f) + w2 * bflo(cq.f)) * bflo(z.f), (w0 * bfhi(a.f) + w1 * bfhi(bq.f) + w2 * bfhi(cq.f)) * bfhi(z.f))
        CMB(x); CMB(y); CMB(z); CMB(w);
#undef CMB
        *(u32x4*)zp = w;
    }
    __syncthreads();
}


#define XB_TMO      128
#define XB_XCNT(j)  (256  + 64 * (j))
#define XB_XSUB(j)  (1280 + 64 * (j))
#define XB_XGEN(j)  (2304 + 64 * (j))
#define XB_TOP      3328
#define XB_TOPGEN   3392
#define XCD_BAR_WORDS 3456
#define XB_SPIN_CAP (1u << 18)

__device__ __forceinline__ unsigned xb_ld(unsigned* p)              { return __hip_atomic_load(p, __ATOMIC_RELAXED, __HIP_MEMORY_SCOPE_AGENT); }
__device__ __forceinline__ unsigned xb_add(unsigned* p, unsigned v) { return __hip_atomic_fetch_add(p, v, __ATOMIC_RELAXED, __HIP_MEMORY_SCOPE_AGENT); }
__device__ __forceinline__ unsigned xb_xcc_id() { return (unsigned)__builtin_amdgcn_s_getreg((3 << 11) | 20) & 0xFu; }
#define XB_SPIN(cond, bar) do { unsigned _sp = 0; while (cond) { __builtin_amdgcn_s_sleep(1); \
    if ((++_sp & 255u) == 0u) { if (xb_ld(&(bar)[XB_TMO])) break; if (_sp > XB_SPIN_CAP) { atomicAdd(&(bar)[XB_TMO], 1u); break; } } } } while (0)

struct XcdBarrier {
    unsigned* bar; unsigned x;
    volatile LAS unsigned* st;
};

__device__ __forceinline__ XcdBarrier xcd_barrier_post(unsigned* bar, volatile LAS unsigned* st) {
    XcdBarrier b; b.bar = bar; b.x = xb_xcc_id(); b.st = st;
    if (threadIdx.x == 0) (void)xb_add(&bar[XB_XCNT(b.x)], 1u);
    return b;
}
__device__ __forceinline__ void xcd_barrier_complete(unsigned* bar, unsigned x, unsigned& nloc, unsigned& nx) {
    const unsigned G = gridDim.x * gridDim.y * gridDim.z;
    unsigned sum, cnt, mine, sp = 0u;
    for (;;) {
        sum = 0u; cnt = 0u; mine = 0u;
#pragma unroll
        for (unsigned j = 0; j < 16; ++j) { const unsigned c = xb_ld(&bar[XB_XCNT(j)]); sum += c; cnt += (c > 0u) ? 1u : 0u; mine = (j == x) ? c : mine; }
        if (sum == G) break;
        __builtin_amdgcn_s_sleep(1);
        if ((++sp & 255u) == 0u) { if (xb_ld(&bar[XB_TMO])) break; if (sp > XB_SPIN_CAP) { atomicAdd(&bar[XB_TMO], 1u); break; } }
    }
    nloc = mine > 0u ? mine : 1u; nx = cnt > 0u ? cnt : 1u;
}

__device__ __forceinline__ void xcd_barrier(const XcdBarrier& b) {
    asm volatile("s_waitcnt vmcnt(0)" ::: "memory");
    __syncthreads();
    if (threadIdx.x == 0) {
        unsigned* bar = b.bar;
        __builtin_amdgcn_s_waitcnt(0);
        unsigned nloc = b.st[0], nx = b.st[1];
        if (nloc == 0u) { xcd_barrier_complete(bar, b.x, nloc, nx); b.st[0] = nloc; b.st[1] = nx; }
        const unsigned old = xb_add(&bar[XB_XSUB(b.x)], 1u);
        const unsigned gen = old / nloc;
        if (old + 1u == (gen + 1u) * nloc) {
            __builtin_amdgcn_fence(__ATOMIC_RELEASE, "agent");
            asm volatile("s_waitcnt vmcnt(0)" ::: "memory");
            const unsigned og = xb_add(&bar[XB_TOP], 1u);
            const unsigned tg = og / nx;
            if (og + 1u == (tg + 1u) * nx) xb_add(&bar[XB_TOPGEN], 1u);
            else XB_SPIN(xb_ld(&bar[XB_TOPGEN]) == tg, bar);
            __builtin_amdgcn_fence(__ATOMIC_ACQUIRE, "agent");
            xb_add(&bar[XB_XGEN(b.x)], 1u);
            asm volatile("s_waitcnt vmcnt(0)" ::: "memory");
        } else {
            XB_SPIN(xb_ld(&bar[XB_XGEN(b.x)]) == gen, bar);
            __builtin_amdgcn_fence(__ATOMIC_ACQUIRE, "agent");
            asm volatile("s_waitcnt vmcnt(0)" ::: "memory");
        }
    }
    __syncthreads();
}

__device__ __forceinline__ float wave_sum(float v) {
#pragma unroll
    for (int o = 1; o < 64; o <<= 1) v += __shfl_xor(v, o);
    return v;
}
__device__ __forceinline__ int rope_pos(int i) { return i < 16 ? 8 * (i >> 2) + (i & 3) : 8 * ((i - 16) >> 2) + 4 + (i & 3); }
__device__ __forceinline__ int dst_row(int mode, int n) {
    if (mode == 1) { if (n < 5504) return n; if (n < 5536) return 5504 + rope_pos(n - 5504); if (n < 6560) return 5632 + (n - 5536); return 6656 + (n - 6560); }
    if (mode == 2) { const int hd = n / 96, e = n - hd * 96; return e < 64 ? hd * 64 + e : 1024 + hd * 32 + rope_pos(e - 64); }
    if (mode == 3) { const int hd = n >> 7, e = n & 127; return e < 64 ? hd * 64 + e : 1024 + hd * 64 + (e - 64); }
    return n;
}
__device__ __forceinline__ void transpose_item(const float* __restrict__ W, int K, int N, bf16_t* WT, int mode, const float* __restrict__ kscale, LAS float* scr, int item, int lane) {
    const int nblk = N / 32, kb = item / nblk, nb = item % nblk, k0 = 64 * kb, n0 = 32 * nb;
#pragma unroll 8
    for (int i = 0; i < 32; ++i) { const int kk = 2 * i + (lane >> 5); float v = W[(size_t)(k0 + kk) * N + n0 + (lane & 31)]; if (kscale) v *= kscale[k0 + kk]; scr[kk * 33 + (lane & 31)] = v; }
    asm volatile("s_waitcnt lgkmcnt(0)" ::: "memory");
    const int c = lane & 7;
#pragma unroll
    for (int j = 0; j < 4; ++j) { const int n = (lane >> 3) + 8 * j; const LAS float* s = scr + (8 * c) * 33 + n;
        u32x4 o; o.x = cvt_pk_bf16(s[0 * 33], s[1 * 33]); o.y = cvt_pk_bf16(s[2 * 33], s[3 * 33]); o.z = cvt_pk_bf16(s[4 * 33], s[5 * 33]); o.w = cvt_pk_bf16(s[6 * 33], s[7 * 33]);
        *(u32x4*)(WT + (size_t)dst_row(mode, n0 + n) * K + k0 + 8 * c) = o; }
    asm volatile("s_waitcnt lgkmcnt(0)" ::: "memory");
}

struct Args { const float* in[16]; float* out; unsigned char* ws; int ph_lo, ph_hi; };
typedef const __attribute__((address_space(4))) Args* KArgs;

__device__ __forceinline__ void convert_weights(KArgs a, int layer, unsigned char* ws, LAS unsigned char* lds, int gw, int NGW, int wave, int lane) {
    LAS float* scr = (LAS float*)(lds + wave * 16384);
    const float* w_in = a->in[6] + (size_t)layer * DM * DIN; const float* w_uq = a->in[8] + (size_t)layer * 256 * 1536; const float* w_ukv = a->in[10] + (size_t)layer * 128 * 2048;
    const float* w_a = a->in[11] + (size_t)layer * 512 * 1024; const float* w_b = a->in[12] + (size_t)layer * 1024 * 1024; const float* w_o = a->in[13] + (size_t)layer * 1024 * 1024;
    const float* qg = a->in[7] + layer * 256; const float* kvg = a->in[9] + layer * 128;
    constexpr int I_IN = 16 * 269, I_UQ = 4 * 48, I_UKV = 2 * 64, I_A = 8 * 32, I_B = 16 * 32, I_O = 16 * 32, NIT = I_IN + I_UQ + I_UKV + I_A + I_B + I_O;
    for (int it = gw; it < NIT; it += NGW) {
        int r = it;
        if (r < I_IN) { transpose_item(w_in, 1024, DIN, (bf16_t*)(ws + WS_WIN), 1, nullptr, scr, r, lane); continue; } r -= I_IN;
        if (r < I_UQ) { transpose_item(w_uq, 256, 1536, (bf16_t*)(ws + WS_WUQ), 2, qg, scr, r, lane); continue; } r -= I_UQ;
        if (r < I_UKV) { transpose_item(w_ukv, 128, 2048, (bf16_t*)(ws + WS_WUKV), 3, kvg, scr, r, lane); continue; } r -= I_UKV;
        if (r < I_A) { transpose_item(w_a, 512, 1024, (bf16_t*)(ws + WS_WA), 0, nullptr, scr, r, lane); continue; } r -= I_A;
        if (r < I_B) { transpose_item(w_b, 1024, 1024, (bf16_t*)(ws + WS_WB), 0, nullptr, scr, r, lane); continue; } r -= I_B;
        transpose_item(w_o, 1024, 1024, (bf16_t*)(ws + WS_WO), 0, nullptr, scr, r, lane);
    }
}
__device__ __forceinline__ void adaln_rows(const float* x, const float* g, const float* mod, bf16_t* H, int gw, int NGW, int lane) {
    for (int m = gw; m < SEQ; m += NGW) {
        const f32x4* xr = (const f32x4*)(x + (size_t)m * DM) + lane; f32x4 v[4]; float s = 0.f;
#pragma unroll
        for (int j = 0; j < 4; ++j) { v[j] = xr[64 * j]; s += (v[j][0] * v[j][0] + v[j][1] * v[j][1]) + (v[j][2] * v[j][2] + v[j][3] * v[j][3]); }
        const float rstd = __builtin_amdgcn_rsqf(wave_sum(s) * (1.f / DM) + EPS);
        u32x2* o8 = (u32x2*)(H + (size_t)m * DM) + lane;
#pragma unroll
        for (int j = 0; j < 4; ++j) { const int c = 256 * j + 4 * lane; const f32x4 gg = *(const f32x4*)(g + c), sh = *(const f32x4*)(mod + c), sc = *(const f32x4*)(mod + 1024 + c);
            const f32x4 y = v[j] * rstd * gg * (sc + 1.f) + sh; u32x2 w; w.x = cvt_pk_bf16(y[0], y[1]); w.y = cvt_pk_bf16(y[2], y[3]); o8[64 * j] = w; }
    }
}
__device__ __forceinline__ void final_rows(float* x, const float* g, int gw, int NGW, int lane) {
    for (int m = gw; m < SEQ; m += NGW) {
        f32x4* xr = (f32x4*)(x + (size_t)m * DM) + lane; f32x4 v[4]; float s = 0.f;
#pragma unroll
        for (int j = 0; j < 4; ++j) { v[j] = xr[64 * j]; s += (v[j][0] * v[j][0] + v[j][1] * v[j][1]) + (v[j][2] * v[j][2] + v[j][3] * v[j][3]); }
        const float rstd = __builtin_amdgcn_rsqf(wave_sum(s) * (1.f / DM) + EPS);
#pragma unroll
        for (int j = 0; j < 4; ++j) { const f32x4 gg = *(const f32x4*)(g + 256 * j + 4 * lane); xr[64 * j] = v[j] * rstd * gg; }
    }
}

#define KARGS(name) KArgs name = (KArgs)__builtin_amdgcn_kernarg_segment_ptr(); asm volatile("" : "+s"(name))
#define GRID_SYNC() do { KARGS(kb_); XcdBarrier b_; b_.bar = (unsigned*)(kb_->ws + WS_BAR); b_.x = xb_xcc_id(); b_.st = (volatile LAS unsigned*)(lds + LDS_ST); xcd_barrier(b_); } while (0)
struct Ids { int G, bx, vcu; };
__device__ __forceinline__ Ids get_ids() { Ids r; r.G = gridDim.x; r.bx = blockIdx.x; r.vcu = (r.G % 8 == 0) ? (r.bx % 8) * (r.G / 8) + r.bx / 8 : r.bx; return r; }
#define FRESH_TID() int tid_ = threadIdx.x; asm volatile("" : "+v"(tid_)); const int tid = tid_, lane = tid & 63; const int wave = __builtin_amdgcn_readfirstlane(tid >> 6); (void)lane; (void)wave

__global__ void __launch_bounds__(NWAVES * 64, 2) fwd_mega(Args a_unused) {
    extern __shared__ __attribute__((aligned(16))) unsigned char lds_raw[];
    LAS unsigned char* lds = (LAS unsigned char*)lds_raw;
    int ph_lo, ph_hi; { KARGS(kp); ph_lo = kp->ph_lo; ph_hi = kp->ph_hi; }
    if (ph_lo < 0) cg::this_grid().sync();
    { KARGS(kb0); if (threadIdx.x < 2) ((LAS unsigned*)(lds + LDS_ST))[threadIdx.x] = 0u; __syncthreads(); (void)xcd_barrier_post((unsigned*)(kb0->ws + WS_BAR), (volatile LAS unsigned*)(lds + LDS_ST)); }
#define IN(k) (ph_lo <= (k) && (k) < ph_hi)
#define SEAM(k) do { if (IN(k) && IN((k) + 1)) GRID_SYNC(); } while (0)

    if (IN(0)) {
        KARGS(ka); FRESH_TID(); const Ids id = get_ids(); const int G = id.G, bx = id.bx;
        unsigned char* ws = ka->ws; const float* cvec = ka->in[1]; const int* pos = (const int*)ka->in[2]; const float* w_ada = ka->in[3]; const float* b_ada = ka->in[4]; const float* rel_bias = ka->in[14];
        float* MOD = (float*)(ws + WS_MOD); float* BT = (float*)(ws + WS_BT); float* COS = (float*)(ws + WS_COS); float* SIN = (float*)(ws + WS_SIN);
        LAS float* red = (LAS float*)(lds + 8 * 16384);
        for (int it = bx; it < 192; it += G) {
            const int l = it / 96, n0 = (it % 96) * 32, col = lane & 31, kh = lane >> 5; const float* wp = w_ada + (size_t)l * DM * 3072 + n0 + col; float s = 0.f;
            const int kbeg = wave * 128 + kh * 64;
#pragma unroll 16
            for (int k = 0; k < 64; ++k) { const float cv = cvec[kbeg + k]; s += silu_f(cv) * wp[(size_t)(kbeg + k) * 3072]; }
            red[wave * 64 + lane] = s; __syncthreads();
            if (tid < 32) { float t = b_ada[l * 3072 + n0 + tid]; for (int i = 0; i < 16; ++i) t += red[i * 32 + tid]; MOD[l * 3072 + n0 + tid] = t; }
            __syncthreads();
        }
        const int gt = id.vcu * 512 + tid, NGT = G * 512;
        for (int i = gt; i < 24 * 192; i += NGT) { const int gh = i / 192, idx = i % 192, g = gh >> 3, j = idx - 32; float v = NEGB;
            if (j >= 0 && j <= 128) { const int dist = j << (2 * g); int bucket;
                if (dist < 16) bucket = dist; else { bucket = 16 + (int)(logf((float)dist / 16.f) / 4.852030263919617f * 16.f); bucket = bucket < 31 ? bucket : 31; }
                v = rel_bias[bucket * 24 + gh] * LOG2E; }
            BT[i] = v; }
        for (int i = gt; i < SEQ * 16; i += NGT) { const int t = i >> 4, f = i & 15; const float inv = 1.0f / exp2f((float)f * (13.287712379549449f / 16.f));
            const float ang = (float)pos[t] * inv; double rev = (double)ang * 0.15915494309189535; rev -= floor(rev);
            COS[i] = __builtin_amdgcn_cosf((float)rev); SIN[i] = __builtin_amdgcn_sinf((float)rev); }
        convert_weights(ka, 0, ws, lds, id.vcu * NWAVES + wave, G * NWAVES, wave, lane);
    }
    SEAM(0);
#pragma unroll
    for (int layer = 0; layer < 2; ++layer) {
        const int pb = 1 + 7 * layer;
        if (IN(pb)) {
            KARGS(ka); FRESH_TID(); const Ids id = get_ids(); unsigned char* ws = ka->ws;
            if (layer == 1) convert_weights(ka, 1, ws, lds, id.vcu * NWAVES + wave, id.G * NWAVES, wave, lane);
            adaln_rows(layer == 0 ? ka->in[0] : (const float*)ka->out, ka->in[5] + layer * DM, (const float*)(ws + WS_MOD) + layer * 3072, (bf16_t*)(ws + WS_H), id.vcu * NWAVES + wave, id.G * NWAVES, lane);
        }
        SEAM(pb + 0);
#if PH&1
        if (IN(pb + 1))
        { KARGS(ka); const Ids id = get_ids(); unsigned char* ws = ka->ws;
          pg8::Gemm g{(const bf16_t*)(ws + WS_H), (const bf16_t*)(ws + WS_WIN), SEQ, 6656, 1024}; pg8::StaticOrder S; S.init(SEQ, 6656, id.G, id.bx);
          EpiIn E{(bf16_t*)(ws + WS_BIG), (bf16_t*)(ws + WS_ZA), (bf16_t*)(ws + WS_ZM), (bf16_t*)(ws + WS_CQ), (bf16_t*)(ws + WS_CKV), (bf16_t*)(ws + WS_KR), (float*)(ws + WS_SSQ), (float*)(ws + WS_SSKV), (const float*)(ws + WS_COS), (const float*)(ws + WS_SIN)};
          GEMM_PHASE(EpiIn, lds, g, S, E); }
#endif
        SEAM(pb + 1);
#if PH&2
        if (IN(pb + 2))
        { KARGS(ka); const Ids id = get_ids(); unsigned char* ws = ka->ws;
          for (int un = id.vcu; un < 256; un += id.G) dil_unit(un >> 5, un & 31, (bf16_t*)(ws + WS_BIG), (bf16_t*)(ws + WS_ZA), (const float*)(ws + WS_BT), (LAS char*)lds);
        }
#endif
        SEAM(pb + 2);
#if PH&4
        if (IN(pb + 3))
        { KARGS(ka); const Ids id = get_ids(); unsigned char* ws = ka->ws; bf16_t* Qm = (bf16_t*)(ws + WS_BIG);
          { pg8::Gemm g{(const bf16_t*)(ws + WS_CQ), (const bf16_t*)(ws + WS_WUQ), SEQ, 1536, 256}; pg8::StaticOrder S; S.init(SEQ, 1536, id.G, id.bx); EpiUq E{Qm, (const float*)(ws + WS_SSQ), (const float*)(ws + WS_COS), (const float*)(ws + WS_SIN)};
            GEMM_PHASE(EpiUq, lds, g, S, E); }
          { pg8::Gemm g{(const bf16_t*)(ws + WS_CKV), (const bf16_t*)(ws + WS_WUKV), SEQ, 2048, 128}; pg8::StaticOrder S; S.init(SEQ, 2048, id.G, id.bx); EpiUkv E{Qm + (size_t)SEQ * 1536, Qm + (size_t)SEQ * 2560, (const float*)(ws + WS_SSKV)};
            GEMM_PHASE(EpiUkv, lds, g, S, E); } }
#endif
        SEAM(pb + 3);
#if PH&8
        if (IN(pb + 4))
        { KARGS(ka); const Ids id = get_ids(); unsigned char* ws = ka->ws; const bf16_t* Qm = (const bf16_t*)(ws + WS_BIG);
          for (int i = 0; i < 4; ++i)
            for (int v = id.vcu; v < 256; v += id.G) { const int s = v & 15, hd = v >> 4; const int qb = i == 0 ? 63 - s : i == 1 ? 32 + s : i == 2 ? 31 - s : s;
                mla_unit(hd, qb, Qm, Qm + (size_t)SEQ * 1536, (const bf16_t*)(ws + WS_KR), Qm + (size_t)SEQ * 2560, (bf16_t*)(ws + WS_ZM), (LAS char*)lds); }
        }
#endif
        SEAM(pb + 4);
#if PH&16
        if (IN(pb + 5))
        { KARGS(ka); const Ids id = get_ids(); unsigned char* ws = ka->ws; bf16_t* MERGED = (bf16_t*)(ws + WS_BIG);
          const bf16_t* H = (const bf16_t*)(ws + WS_H); const bf16_t* WIN = (const bf16_t*)(ws + WS_WIN);
          for (int un = id.vcu; un < 1024; un += id.G) p4_unit(un >> 3, un & 7, H, (const bf16_t*)(ws + WS_ZA), (const bf16_t*)(ws + WS_ZM), WIN + (size_t)6656 * 1024, WIN + (size_t)7680 * 1024, (const bf16_t*)(ws + WS_WA), (const bf16_t*)(ws + WS_WB), MERGED, (LAS char*)lds); }
#endif
        SEAM(pb + 5);
#if PH&32
        if (IN(pb + 6))
        { KARGS(ka); const Ids id = get_ids(); unsigned char* ws = ka->ws;
          pg8::Gemm g{(const bf16_t*)(ws + WS_BIG), (const bf16_t*)(ws + WS_WO), SEQ, 1024, 1024}; pg8::StaticOrder S; S.init(SEQ, 1024, id.G, id.bx);
          EpiRes E{layer == 0 ? ka->in[0] : (const float*)ka->out, ka->out, (const float*)(ws + WS_MOD) + layer * 3072 + 2048};
          GEMM_PHASE(EpiRes, lds, g, S, E); }
#endif
        SEAM(pb + 6);
    }
    if (IN(15)) { KARGS(ka); FRESH_TID(); const Ids id = get_ids(); final_rows(ka->out, ka->in[15], id.vcu * NWAVES + wave, id.G * NWAVES, lane); }
}


extern "C" void kernel_launch(void* const* d_in, const int* in_sizes, int n_in, void* d_out, int out_size, void* d_ws, size_t ws_size, hipStream_t stream) {
    static int grid = 0;
    if (grid == 0) {
        if (n_in != 16 || out_size != SEQ * DM || ws_size < WS_END) { fprintf(stderr, "kernel_launch: unexpected problem: n_in %d out %d ws %zu (need %zu)\n", n_in, out_size, ws_size, (size_t)WS_END); grid = -1; return; }
        int dev = 0, cus = 0, per_cu = 0;
        if (hipGetDevice(&dev) != hipSuccess || hipDeviceGetAttribute(&cus, hipDeviceAttributeMultiprocessorCount, dev) != hipSuccess) { grid = -1; return; }
        if (hipFuncSetAttribute((const void*)fwd_mega, hipFuncAttributeMaxDynamicSharedMemorySize, LDS_BYTES) != hipSuccess) { fprintf(stderr, "kernel_launch: hipFuncSetAttribute failed\n"); grid = -1; return; }
        if (hipOccupancyMaxActiveBlocksPerMultiprocessor(&per_cu, (const void*)fwd_mega, NWAVES * 64, LDS_BYTES) != hipSuccess || per_cu < 1) fprintf(stderr, "kernel_launch: occupancy query says %d\n", per_cu);
        (void)hipGetLastError();
        grid = cus;
    }
    if (grid < 0) return;
    if (hipMemsetAsync((char*)d_ws + WS_BAR, 0, 16384, stream) != hipSuccess) { fprintf(stderr, "kernel_launch: memset failed\n"); return; }
    Args a{};
    for (int i = 0; i < 16; ++i) a.in[i] = (const float*)d_in[i];
    a.out = (float*)d_out; a.ws = (unsigned char*)d_ws;
#if N_LAUNCH == 1
    a.ph_lo = 0; a.ph_hi = 16;
    void* args[] = {&a};
    hipError_t e = hipLaunchCooperativeKernel((const void*)fwd_mega, dim3(grid), dim3(NWAVES * 64), args, LDS_BYTES, stream);
    if (e != hipSuccess) fprintf(stderr, "kernel_launch: cooperative launch failed: %s (grid %d)\n", hipGetErrorString(e), grid);
#else
    for (int p = 0; p < 16; ++p) { a.ph_lo = p; a.ph_hi = p + 1; hipLaunchKernelGGL(fwd_mega, dim3(grid), dim3(NWAVES * 64), LDS_BYTES, stream, a); }
#endif
}
```
